# Optimizing an MI355X kernel written in HIP

```python
import math
import jax, jax.numpy as jnp
from jax import lax
import numpy as np

D_MODEL = 2048
BATCH = 1
SEQ = 8192
DEPTH = 4

CHUNK = 64
HEAD_DIM = 128
A_Q_HEADS = 8
A_KV_HEADS = 2
A_WINDOW = 128
A_PREV_CHUNKS = A_WINDOW // CHUNK
B_HEADS = 4
B_QK_DIM = HEAD_DIM // 2
B_V_DIM = HEAD_DIM
B_QBLOCK = 128
C_HEADS = 4
C_PREV_CHUNKS = 8
REL_CLIP = 256
FFN_HIDDEN = int(math.ceil(8 * D_MODEL / 3 / 256)) * 256

ROPE_THETA = 10000.0
LN_EPS = 1e-5
DEEPNORM_ALPHA = (2 * DEPTH) ** 0.25
DEEPNORM_BETA = (8 * DEPTH) ** -0.25
NEG_INF = -1e30

A_Q_W = A_Q_HEADS * HEAD_DIM
A_KV_W = A_KV_HEADS * HEAD_DIM
B_QK_W = B_HEADS * 2 * B_QK_DIM
B_V_W = B_HEADS * B_V_DIM
C_W = C_HEADS * HEAD_DIM
IN_SPLITS = [A_Q_W, A_KV_W, A_KV_W, B_QK_W, B_QK_W, B_V_W, C_W, C_W, C_W]
V_SEGMENTS = (2, 5, 8)
IN_WIDTH = sum(IN_SPLITS)
IN_OFFSETS = [int(o) for o in np.cumsum(IN_SPLITS)[:-1]]

kernel_name = "hybrid_chunk_causal_gated_trunk"


def layer_norm(x, g, b):
    xf = x.astype(jnp.float32)
    mu = jnp.mean(xf, axis=-1, keepdims=True)
    var = jnp.mean(jnp.square(xf - mu), axis=-1, keepdims=True)
    y = (xf - mu) * lax.rsqrt(var + LN_EPS) * g.astype(jnp.float32) + b.astype(jnp.float32)
    return y.astype(x.dtype)


def rope_tables(seq, dim):
    pos = jnp.arange(seq, dtype=jnp.float32)
    inv = 1.0 / (ROPE_THETA ** (jnp.arange(0, dim, 2, dtype=jnp.float32) / dim))
    ang = pos[:, None] * inv[None, :]
    ang = jnp.concatenate([ang, ang], axis=-1)
    return jnp.cos(ang), jnp.sin(ang)


def apply_rope(t, cos, sin):
    half = t.shape[-1] // 2
    t1, t2 = t[..., :half], t[..., half:]
    rot = jnp.concatenate([-t2, t1], axis=-1)
    return t * cos.astype(t.dtype) + rot * sin.astype(t.dtype)


def to_heads(t, h):
    b, s, _ = t.shape
    return t.reshape(b, s, h, -1).transpose(0, 2, 1, 3)


def from_heads(t):
    b, h, s, d = t.shape
    return t.transpose(0, 2, 1, 3).reshape(b, s, h * d)


def band_gather(t, n_prev):
    b, h, s, d = t.shape
    nc = s // CHUNK
    tc = t.reshape(b, h, nc, CHUNK, d)
    tp = jnp.pad(tc, ((0, 0), (0, 0), (n_prev, 0), (0, 0), (0, 0)))
    band = jnp.stack([tp[:, :, i:i + nc] for i in range(n_prev + 1)], axis=3)
    return band.reshape(b, h, nc, (n_prev + 1) * CHUNK, d)


def band_valid(nc, n_prev):
    src = jnp.arange(nc)[:, None] + jnp.arange(n_prev + 1)[None, :] - n_prev
    return jnp.repeat(src >= 0, CHUNK, axis=1)


def window_sink_gqa(q, k, v, sinks):
    b, hq, s, d = q.shape
    hkv = k.shape[1]
    g = hq // hkv
    nc = s // CHUNK
    qc = q.reshape(b, hkv, g, nc, CHUNK, d)
    kb = band_gather(k, A_PREV_CHUNKS)
    vb = band_gather(v, A_PREV_CHUNKS)
    sc = jnp.einsum('bkgcqd,bkcjd->bkgcqj', qc, kb).astype(jnp.float32) * (d ** -0.5)
    valid = band_valid(nc, A_PREV_CHUNKS)
    sc = jnp.where(valid[:, None, :], sc, NEG_INF)
    sink = jnp.broadcast_to(sinks.astype(jnp.float32).reshape(1, hkv, g, 1, 1, 1), sc.shape[:-1] + (1,))
    p = jax.nn.softmax(jnp.concatenate([sc, sink], axis=-1), axis=-1)[..., :-1]
    o = jnp.einsum('bkgcqj,bkcjd->bkgcqd', p.astype(v.dtype), vb)
    return o.reshape(b, hq, s, d)


def diff_attention(q, k, v, lam, sub_g, lam_init):
    b, h, _, s, dq = q.shape
    dv = v.shape[-1]
    nb = s // B_QBLOCK
    qb = jnp.moveaxis(q.reshape(b, h, 2, nb, B_QBLOCK, dq), 3, 0)
    kchunk = jnp.arange(s) // CHUNK
    scale = dq ** -0.5

    def block(args):
        qi, bi = args
        qchunk = (bi * B_QBLOCK + jnp.arange(B_QBLOCK)) // CHUNK
        mask = kchunk[None, :] <= qchunk[:, None]
        sc = jnp.einsum('bhmqd,bhmkd->bhmqk', qi, k).astype(jnp.float32) * scale
        p = jax.nn.softmax(jnp.where(mask, sc, NEG_INF), axis=-1)
        a = p[:, :, 0] - lam * p[:, :, 1]
        return jnp.einsum('bhqk,bhkd->bhqd', a.astype(v.dtype), v)

    o = lax.map(block, (qb, jnp.arange(nb)))
    o = jnp.moveaxis(o, 0, 2).reshape(b, h, s, dv)
    of = o.astype(jnp.float32)
    of = of * lax.rsqrt(jnp.mean(jnp.square(of), axis=-1, keepdims=True) + LN_EPS)
    of = of * sub_g.astype(jnp.float32) * (1.0 - lam_init)
    return of.astype(v.dtype)


def chunk_relbias_attention(q, k, v, rel_bias):
    b, h, s, d = q.shape
    nc = s // CHUNK
    j = (C_PREV_CHUNKS + 1) * CHUNK
    qc = q.reshape(b, h, nc, CHUNK, d)
    kb = band_gather(k, C_PREV_CHUNKS)
    vb = band_gather(v, C_PREV_CHUNKS)
    dist = C_PREV_CHUNKS * CHUNK + jnp.arange(CHUNK)[:, None] - jnp.arange(j)[None, :]
    idx = jnp.clip(dist, -REL_CLIP, REL_CLIP) + REL_CLIP
    bias = rel_bias.astype(jnp.float32)[:, idx]
    sc = jnp.einsum('bhcqd,bhcjd->bhcqj', qc, kb).astype(jnp.float32) * (d ** -0.5) + bias[None, :, None]
    valid = band_valid(nc, C_PREV_CHUNKS)
    sc = jnp.where(valid[:, None, :], sc, NEG_INF)
    p = jax.nn.softmax(sc, axis=-1)
    o = jnp.einsum('bhcqj,bhcjd->bhcqd', p.astype(v.dtype), vb)
    return o.reshape(b, h, s, d)


def setup_inputs(seed: int = 0) -> dict:
    key = jax.random.key(seed)
    ks = jax.random.split(key, 24)
    f32 = jnp.float32
    col_scale = jnp.concatenate([
        jnp.full((w,), DEEPNORM_BETA if i in V_SEGMENTS else 1.0, f32) for i, w in enumerate(IN_SPLITS)])
    nrm = lambda k, shape: jax.random.normal(k, shape, f32)
    return {
        "x": nrm(ks[0], (BATCH, SEQ, D_MODEL)),
        "w_in": nrm(ks[1], (DEPTH, D_MODEL, IN_WIDTH)) * (D_MODEL ** -0.5) * col_scale,
        "sinks": nrm(ks[2], (DEPTH, A_Q_HEADS)) * 0.5,
        "lambda_q1": nrm(ks[3], (DEPTH, B_QK_DIM)) * 0.1,
        "lambda_k1": nrm(ks[4], (DEPTH, B_QK_DIM)) * 0.1,
        "lambda_q2": nrm(ks[5], (DEPTH, B_QK_DIM)) * 0.1,
        "lambda_k2": nrm(ks[6], (DEPTH, B_QK_DIM)) * 0.1,
        "diff_norm_g": 1.0 + 0.02 * nrm(ks[7], (DEPTH, B_V_DIM)),
        "rel_bias": nrm(ks[8], (DEPTH, C_HEADS, 2 * REL_CLIP + 1)) * 0.1,
        "w_br_a": nrm(ks[9], (DEPTH, A_Q_W, D_MODEL)) * (A_Q_W ** -0.5),
        "w_br_b": nrm(ks[10], (DEPTH, B_V_W, D_MODEL)) * (B_V_W ** -0.5),
        "w_br_c": nrm(ks[11], (DEPTH, C_W, D_MODEL)) * (C_W ** -0.5),
        "w_gate": nrm(ks[12], (DEPTH, D_MODEL, 3 * D_MODEL)) * (D_MODEL ** -0.5),
        "b_gate": nrm(ks[13], (DEPTH, 3 * D_MODEL)) * 0.02,
        "w_out": nrm(ks[14], (DEPTH, D_MODEL, D_MODEL)) * (D_MODEL ** -0.5) * DEEPNORM_BETA,
        "ln1_g": 1.0 + 0.02 * nrm(ks[15], (DEPTH, D_MODEL)),
        "ln1_b": 0.02 * nrm(ks[16], (DEPTH, D_MODEL)),
        "w_ffn_in": nrm(ks[17], (DEPTH, D_MODEL, 2 * FFN_HIDDEN)) * (D_MODEL ** -0.5),
        "w_ffn_out": nrm(ks[18], (DEPTH, FFN_HIDDEN, D_MODEL)) * (FFN_HIDDEN ** -0.5) * DEEPNORM_BETA,
        "ln2_g": 1.0 + 0.02 * nrm(ks[19], (DEPTH, D_MODEL)),
        "ln2_b": 0.02 * nrm(ks[20], (DEPTH, D_MODEL)),
    }


def reference(x, w_in, sinks, lambda_q1, lambda_k1, lambda_q2, lambda_k2, diff_norm_g, rel_bias,
              w_br_a, w_br_b, w_br_c, w_gate, b_gate, w_out, ln1_g, ln1_b,
              w_ffn_in, w_ffn_out, ln2_g, ln2_b):
    b, s, _ = x.shape
    cos_a, sin_a = rope_tables(s, HEAD_DIM)
    cos_b, sin_b = rope_tables(s, B_QK_DIM)
    for l in range(DEPTH):
        h = x @ w_in[l]
        aq, ak, av, bq, bk, bv, cq, ck, cv = jnp.split(h, IN_OFFSETS, axis=-1)
        aq = apply_rope(to_heads(aq, A_Q_HEADS), cos_a, sin_a)
        ak = apply_rope(to_heads(ak, A_KV_HEADS), cos_a, sin_a)
        ya = from_heads(window_sink_gqa(aq, ak, to_heads(av, A_KV_HEADS), sinks[l]))
        bq = apply_rope(bq.reshape(b, s, B_HEADS, 2, B_QK_DIM).transpose(0, 2, 3, 1, 4), cos_b, sin_b)
        bk = apply_rope(bk.reshape(b, s, B_HEADS, 2, B_QK_DIM).transpose(0, 2, 3, 1, 4), cos_b, sin_b)
        lam_init = 0.8 - 0.6 * math.exp(-0.3 * l)
        lam = (jnp.exp(jnp.sum(lambda_q1[l].astype(jnp.float32) * lambda_k1[l].astype(jnp.float32)))
               - jnp.exp(jnp.sum(lambda_q2[l].astype(jnp.float32) * lambda_k2[l].astype(jnp.float32)))
               + lam_init)
        yb = from_heads(diff_attention(bq, bk, to_heads(bv, B_HEADS), lam, diff_norm_g[l], lam_init))
        yc = from_heads(chunk_relbias_attention(to_heads(cq, C_HEADS), to_heads(ck, C_HEADS),
                                                to_heads(cv, C_HEADS), rel_bias[l]))
        ga, gb, gc = jnp.split(jax.nn.sigmoid(x @ w_gate[l] + b_gate[l]), 3, axis=-1)
        mix = ga * (ya @ w_br_a[l]) + gb * (yb @ w_br_b[l]) + gc * (yc @ w_br_c[l])
        x = layer_norm(DEEPNORM_ALPHA * x + mix @ w_out[l], ln1_g[l], ln1_b[l])
        f_gate, f_up = jnp.split(x @ w_ffn_in[l], 2, axis=-1)
        x = layer_norm(DEEPNORM_ALPHA * x + (jax.nn.silu(f_gate) * f_up) @ w_ffn_out[l], ln2_g[l], ln2_b[l])
    return x
```

```cpp
#include <hip/hip_runtime.h>
#include <cstdio>
#include <cstdint>
#include <cmath>

typedef unsigned short bf16;
typedef short bf16x8 __attribute__((ext_vector_type(8)));
typedef float f32x4 __attribute__((ext_vector_type(4)));
typedef float f32x2 __attribute__((ext_vector_type(2)));
typedef unsigned u32x4 __attribute__((ext_vector_type(4)));
typedef unsigned u32x2 __attribute__((ext_vector_type(2)));

constexpr int S = 8192, DM = 2048, DEPTH = 4, INW = 4608, GW = 6144, FH = 5632;
constexpr float LN_EPS = 1e-5f;
constexpr float ALPHA = 1.6817928305074290f;
constexpr size_t MiB = 1u << 20;

constexpr size_t WL_W1 = 0;
constexpr size_t WL_BA = WL_W1 + (size_t)10752 * 2048 * 2;
constexpr size_t WL_BB = WL_BA + (size_t)2048 * 1024 * 2;
constexpr size_t WL_BC = WL_BB + (size_t)2048 * 512 * 2;
constexpr size_t WL_WO = WL_BC + (size_t)2048 * 512 * 2;
constexpr size_t WL_F1 = WL_WO + (size_t)2048 * 2048 * 2;
constexpr size_t WL_F2 = WL_F1 + (size_t)11264 * 2048 * 2;
constexpr size_t WL_SIZE = WL_F2 + (size_t)2048 * 5632 * 2;
constexpr size_t WS_CTL = 0;
constexpr size_t WS_W = 1 * MiB;
constexpr size_t WS_XB = WS_W + 4 * WL_SIZE;
constexpr size_t WS_QKV = WS_XB + (size_t)S * DM * 2;
constexpr size_t WS_G = WS_QKV + (size_t)S * INW * 2;
constexpr size_t WS_Y = WS_G + (size_t)S * GW * 2;
constexpr size_t WS_MIXB = WS_Y + (size_t)S * DM * 2;
constexpr size_t WS_F = WS_MIXB + (size_t)S * DM * 2;
constexpr size_t WS_CSA = WS_F + (size_t)S * FH * 2;
constexpr size_t WS_CSB = WS_CSA + (size_t)S * 64 * 2 * 4;
constexpr size_t WS_V32 = WS_CSB + (size_t)S * 32 * 2 * 4;
constexpr size_t WS_MIX32 = WS_V32 + (size_t)S * DM * 4;
constexpr size_t WS_H32 = WS_MIX32 + (size_t)S * DM * 4;
constexpr size_t WS_END = WS_H32 + (size_t)S * INW * 4;
constexpr size_t HS = (size_t)S * 128;
constexpr size_t O_QA = 0, O_KA = 8 * HS, O_VA = 10 * HS, O_QB = 12 * HS, O_KB = 16 * HS, O_VB = 20 * HS, O_QC = 24 * HS, O_KC = 28 * HS, O_VC = 32 * HS;

__device__ __forceinline__ unsigned f2bf(float f) { unsigned u = __builtin_bit_cast(unsigned, f); return (u + 0x7fffu + ((u >> 16) & 1u)) >> 16; }
__device__ __forceinline__ unsigned pk2(float lo, float hi) { return f2bf(lo) | (f2bf(hi) << 16); }
__device__ __forceinline__ float bf2f(unsigned short b) { return __builtin_bit_cast(float, (unsigned)b << 16); }
__device__ __forceinline__ float wave_sum(float v) {
#pragma unroll
    for (int o = 1; o < 64; o <<= 1) v += __shfl_xor(v, o);
    return v;
}
__device__ __forceinline__ float wave_max(float v) {
#pragma unroll
    for (int o = 1; o < 64; o <<= 1) v = fmaxf(v, __shfl_xor(v, o));
    return v;
}

__device__ __forceinline__ int colmap(int kind, int nb) {
    if (kind == 1) { return ((nb & 1) ? FH : 0) + (nb >> 1) * 16; }
    return nb * 16;
}
__global__ __launch_bounds__(256) void k_wcvt(const float* __restrict__ W, bf16* __restrict__ WT, long K_, long Nsrc_, long Ndst_, long kind_, size_t src_layer_stride, size_t dst_layer_stride) {
    const int K = (int)K_, Nsrc = (int)Nsrc_, kind = (int)kind_; (void)Ndst_;
    __shared__ float tile[64][33];
    const int tid = threadIdx.x, l = blockIdx.z;
    const float* Wl = W + (size_t)l * src_layer_stride; bf16* WTl = (bf16*)((char*)WT + (size_t)l * dst_layer_stride);
    const int n0 = blockIdx.x * 32, k0 = blockIdx.y * 64;
    const int i = tid & 15, kk = tid >> 4;
#pragma unroll
    for (int g = 0; g < 2; ++g) { const int cb = colmap(kind, (n0 >> 4) + g);
#pragma unroll
        for (int p = 0; p < 4; ++p) tile[kk + 16 * p][g * 16 + i] = Wl[(size_t)(k0 + kk + 16 * p) * Nsrc + cb + i]; }
    __syncthreads();
    const int n = tid >> 3, c = tid & 7;
    u32x4 o; o.x = pk2(tile[8 * c + 0][n], tile[8 * c + 1][n]); o.y = pk2(tile[8 * c + 2][n], tile[8 * c + 3][n]); o.z = pk2(tile[8 * c + 4][n], tile[8 * c + 5][n]); o.w = pk2(tile[8 * c + 6][n], tile[8 * c + 7][n]);
    *(u32x4*)(WTl + (size_t)(n0 + n) * K + k0 + 8 * c) = o;
}
__global__ __launch_bounds__(256) void k_xcvt(const float* __restrict__ x, bf16* __restrict__ xb) {
    const size_t i = ((size_t)blockIdx.x * 256 + threadIdx.x) * 4;
    const f32x4 v = *(const f32x4*)(x + i); u32x2 o; o.x = pk2(v[0], v[1]); o.y = pk2(v[2], v[3]); *(u32x2*)(xb + i) = o;
}
__global__ __launch_bounds__(256) void k_rope_tab(float* __restrict__ csa, float* __restrict__ csb) {
    const int idx = blockIdx.x * 256 + threadIdx.x;
    if (idx >= S * 96) return;
    const int s = idx / 96, j = idx % 96;
    if (j < 64) { const float e = (float)(2 * j) / 128.0f; const float inv = 1.0f / powf(10000.0f, e); const float ang = (float)s * inv;
        csa[((size_t)s * 64 + j) * 2] = (float)cos((double)ang); csa[((size_t)s * 64 + j) * 2 + 1] = (float)sin((double)ang); }
    else { const int i = j - 64; const float e = (float)(2 * i) / 64.0f; const float inv = 1.0f / powf(10000.0f, e); const float ang = (float)s * inv;
        csb[((size_t)s * 32 + i) * 2] = (float)cos((double)ang); csb[((size_t)s * 32 + i) * 2 + 1] = (float)sin((double)ang); }
}

template <class Epi>
__global__ __launch_bounds__(256) void k_gemm(const bf16* __restrict__ A, long lda_, const bf16* __restrict__ Bt, long K_, Epi epi) {
    const int lda = (int)lda_, K = (int)K_;
    const int tid = threadIdx.x, wid = tid >> 6, lane = tid & 63, fr = lane & 15, fq = lane >> 4;
    const int m0 = blockIdx.y * 128 + (wid >> 1) * 64, n0 = blockIdx.x * 128 + (wid & 1) * 64;
    f32x4 acc[4][4];
#pragma unroll
    for (int mi = 0; mi < 4; ++mi)
#pragma unroll
        for (int ni = 0; ni < 4; ++ni) acc[mi][ni] = (f32x4){0.f, 0.f, 0.f, 0.f};
    for (int k0 = 0; k0 < K; k0 += 32) {
        bf16x8 a[4], b[4];
#pragma unroll
        for (int mi = 0; mi < 4; ++mi) a[mi] = *(const bf16x8*)(A + (size_t)(m0 + mi * 16 + fr) * lda + k0 + fq * 8);
#pragma unroll
        for (int ni = 0; ni < 4; ++ni) b[ni] = *(const bf16x8*)(Bt + (size_t)(n0 + ni * 16 + fr) * K + k0 + fq * 8);
#pragma unroll
        for (int mi = 0; mi < 4; ++mi)
#pragma unroll
            for (int ni = 0; ni < 4; ++ni) acc[mi][ni] = __builtin_amdgcn_mfma_f32_16x16x32_bf16(b[ni], a[mi], acc[mi][ni], 0, 0, 0);
    }
    epi(acc, m0, n0, fr, fq);
}
struct EpiH32 { float* H; long ldc;
    __device__ __forceinline__ void operator()(const f32x4 (&acc)[4][4], int m0, int n0, int fr, int fq) const {
#pragma unroll
        for (int mi = 0; mi < 4; ++mi)
#pragma unroll
            for (int ni = 0; ni < 4; ++ni) *(f32x4*)(H + (size_t)(m0 + mi * 16 + fr) * ldc + n0 + ni * 16 + 4 * fq) = acc[mi][ni]; } };
struct EpiGate { bf16* G; const float* bias;
    __device__ __forceinline__ void operator()(const f32x4 (&acc)[4][4], int m0, int n0, int fr, int fq) const {
#pragma unroll
        for (int mi = 0; mi < 4; ++mi)
#pragma unroll
            for (int ni = 0; ni < 4; ++ni) { const int col = n0 + ni * 16 + 4 * fq; const f32x4 b = *(const f32x4*)(bias + col); f32x4 v = acc[mi][ni] + b;
#pragma unroll
                for (int r = 0; r < 4; ++r) v[r] = 1.0f / (1.0f + expf(-v[r]));
                u32x2 o; o.x = pk2(v[0], v[1]); o.y = pk2(v[2], v[3]); *(u32x2*)(G + (size_t)(m0 + mi * 16 + fr) * GW + col) = o; } } };
template <int MODE> struct EpiBr { const bf16* G; long goff; float* MIX32; bf16* MIXB;
    __device__ __forceinline__ void operator()(const f32x4 (&acc)[4][4], int m0, int n0, int fr, int fq) const {
#pragma unroll
        for (int mi = 0; mi < 4; ++mi)
#pragma unroll
            for (int ni = 0; ni < 4; ++ni) { const int row = m0 + mi * 16 + fr, col = n0 + ni * 16 + 4 * fq;
                const u32x2 gw = *(const u32x2*)(G + (size_t)row * GW + goff + col);
                f32x4 g; g[0] = bf2f(gw.x & 0xffff); g[1] = bf2f(gw.x >> 16); g[2] = bf2f(gw.y & 0xffff); g[3] = bf2f(gw.y >> 16);
                f32x4 v = acc[mi][ni] * g; float* mp = MIX32 + (size_t)row * DM + col;
                if (MODE >= 1) v += *(const f32x4*)mp;
                if (MODE <= 1) *(f32x4*)mp = v;
                else { u32x2 o; o.x = pk2(v[0], v[1]); o.y = pk2(v[2], v[3]); *(u32x2*)(MIXB + (size_t)row * DM + col) = o; } } } };
struct EpiRes { const float* xres; float* V32;
    __device__ __forceinline__ void operator()(const f32x4 (&acc)[4][4], int m0, int n0, int fr, int fq) const {
#pragma unroll
        for (int mi = 0; mi < 4; ++mi)
#pragma unroll
            for (int ni = 0; ni < 4; ++ni) { const size_t off = (size_t)(m0 + mi * 16 + fr) * DM + n0 + ni * 16 + 4 * fq;
                *(f32x4*)(V32 + off) = *(const f32x4*)(xres + off) * ALPHA + acc[mi][ni]; } } };
struct EpiSwiGLU { bf16* F;
    __device__ __forceinline__ void operator()(const f32x4 (&acc)[4][4], int m0, int n0, int fr, int fq) const {
#pragma unroll
        for (int mi = 0; mi < 4; ++mi)
#pragma unroll
            for (int t = 0; t < 2; ++t) { const f32x4 g = acc[mi][2 * t], u = acc[mi][2 * t + 1]; f32x4 v;
#pragma unroll
                for (int r = 0; r < 4; ++r) v[r] = g[r] / (1.0f + expf(-g[r])) * u[r];
                u32x2 o; o.x = pk2(v[0], v[1]); o.y = pk2(v[2], v[3]);
                *(u32x2*)(F + (size_t)(m0 + mi * 16 + fr) * FH + (n0 >> 1) + 16 * t + 4 * fq) = o; } } };

__global__ __launch_bounds__(256) void k_rope_split(const float* __restrict__ H, bf16* __restrict__ QKV, const float* __restrict__ csa, const float* __restrict__ csb) {
    const int s = blockIdx.x; const float* h = H + (size_t)s * INW;
    for (int j = threadIdx.x; j < INW; j += 256) {
        float val = h[j]; size_t dst;
        if (j < 1280) {
            const int hd = j >> 7, d = j & 127, i = d & 63; const float c = csa[((size_t)s * 64 + i) * 2], sn = csa[((size_t)s * 64 + i) * 2 + 1];
            val = d < 64 ? h[j] * c - h[j + 64] * sn : h[j] * c + h[j - 64] * sn;
            dst = (hd < 8 ? O_QA + (size_t)hd * HS : O_KA + (size_t)(hd - 8) * HS) + (size_t)s * 128 + d;
        } else if (j < 1536) { const int jj = j - 1280; dst = O_VA + (size_t)(jj >> 7) * HS + (size_t)s * 128 + (jj & 127); }
        else if (j < 2560) {
            const int jj = j - 1536, hd = jj >> 7, dd = jj & 127, d = dd & 63, i = d & 31; const float c = csb[((size_t)s * 32 + i) * 2], sn = csb[((size_t)s * 32 + i) * 2 + 1];
            val = d < 32 ? h[j] * c - h[j + 32] * sn : h[j] * c + h[j - 32] * sn;
            dst = (hd < 4 ? O_QB + (size_t)hd * HS : O_KB + (size_t)(hd - 4) * HS) + (size_t)s * 128 + dd;
        } else { const int jj = j - 2560; dst = O_VB + (size_t)(jj >> 7) * HS + (size_t)s * 128 + (jj & 127); }
        QKV[dst] = (bf16)f2bf(val);
    }
}

__global__ __launch_bounds__(256) void k_ln(const float* __restrict__ V, const float* __restrict__ g, const float* __restrict__ b, float* __restrict__ xo, bf16* __restrict__ xb) {
    const int row = blockIdx.x * 4 + (threadIdx.x >> 6), lane = threadIdx.x & 63;
    const f32x4* vr = (const f32x4*)(V + (size_t)row * DM) + lane;
    f32x4 v[8]; float s = 0.f;
#pragma unroll
    for (int j = 0; j < 8; ++j) { v[j] = vr[64 * j]; s += (v[j][0] + v[j][1]) + (v[j][2] + v[j][3]); }
    const float mean = wave_sum(s) * (1.f / DM); float q = 0.f;
#pragma unroll
    for (int j = 0; j < 8; ++j) { v[j] = v[j] - mean; q += (v[j][0] * v[j][0] + v[j][1] * v[j][1]) + (v[j][2] * v[j][2] + v[j][3] * v[j][3]); }
    const float rstd = 1.0f / sqrtf(wave_sum(q) * (1.f / DM) + LN_EPS);
#pragma unroll
    for (int j = 0; j < 8; ++j) { const int col = 4 * lane + 256 * j; const f32x4 gg = *(const f32x4*)(g + col), bb = *(const f32x4*)(b + col);
        const f32x4 y = v[j] * rstd * gg + bb; *(f32x4*)(xo + (size_t)row * DM + col) = y;
        u32x2 o; o.x = pk2(y[0], y[1]); o.y = pk2(y[2], y[3]); *(u32x2*)(xb + (size_t)row * DM + col) = o; }
}

template <int N> __device__ __forceinline__ void load_q(float (&q)[N], const bf16* p) {
#pragma unroll
    for (int i = 0; i < N / 8; ++i) { const u32x4 w = *(const u32x4*)(p + 8 * i);
        q[8 * i + 0] = bf2f(w.x & 0xffff); q[8 * i + 1] = bf2f(w.x >> 16); q[8 * i + 2] = bf2f(w.y & 0xffff); q[8 * i + 3] = bf2f(w.y >> 16);
        q[8 * i + 4] = bf2f(w.z & 0xffff); q[8 * i + 5] = bf2f(w.z >> 16); q[8 * i + 6] = bf2f(w.w & 0xffff); q[8 * i + 7] = bf2f(w.w >> 16); }
}
template <int N> __device__ __forceinline__ float dot_q(const float (&q)[N], const bf16* p) {
    float a = 0.f;
#pragma unroll
    for (int i = 0; i < N / 8; ++i) { const u32x4 w = *(const u32x4*)(p + 8 * i);
        a += q[8 * i + 0] * bf2f(w.x & 0xffff); a += q[8 * i + 1] * bf2f(w.x >> 16); a += q[8 * i + 2] * bf2f(w.y & 0xffff); a += q[8 * i + 3] * bf2f(w.y >> 16);
        a += q[8 * i + 4] * bf2f(w.z & 0xffff); a += q[8 * i + 5] * bf2f(w.z >> 16); a += q[8 * i + 6] * bf2f(w.w & 0xffff); a += q[8 * i + 7] * bf2f(w.w >> 16); }
    return a;
}
__device__ __forceinline__ void osm_tile(float sc, float& m, float& l, float& o0, float& o1, const bf16* Vt, int lane) {
    const float tm = wave_max(sc), mn = fmaxf(m, tm), al = expf(m - mn), p = expf(sc - mn);
    l = l * al + wave_sum(p); o0 *= al; o1 *= al; m = mn;
#pragma unroll 16
    for (int k = 0; k < 64; ++k) { const float pk = __shfl(p, k); const unsigned w = *(const unsigned*)(Vt + (size_t)k * 128 + 2 * lane);
        o0 += pk * bf2f(w & 0xffff); o1 += pk * bf2f(w >> 16); }
}
__global__ __launch_bounds__(256) void k_attn_a(const bf16* __restrict__ QKV, const float* __restrict__ sinks, bf16* __restrict__ Y) {
    const int gw = blockIdx.x * 4 + (threadIdx.x >> 6), lane = threadIdx.x & 63; const int hq = gw / S, s = gw % S, kv = hq >> 2, c = s >> 6;
    float q[128]; load_q<128>(q, QKV + O_QA + (size_t)hq * HS + (size_t)s * 128);
    float m = sinks[hq], l = 1.0f, o0 = 0.f, o1 = 0.f;
    const bf16* Kh = QKV + O_KA + (size_t)kv * HS; const bf16* Vh = QKV + O_VA + (size_t)kv * HS;
    for (int t = (c >= 2 ? c - 2 : 0); t <= c; ++t) {
        const float sc = dot_q<128>(q, Kh + (size_t)(64 * t + lane) * 128) * 0.08838834764831845f;
        osm_tile(sc, m, l, o0, o1, Vh + (size_t)(64 * t) * 128, lane);
    }
    *(unsigned*)(Y + (size_t)s * DM + hq * 128 + 2 * lane) = pk2(o0 / l, o1 / l);
}
__global__ __launch_bounds__(256) void k_attn_c(const bf16* __restrict__ QKV, const float* __restrict__ relb, bf16* __restrict__ Y) {
    const int gw = blockIdx.x * 4 + (threadIdx.x >> 6), lane = threadIdx.x & 63; const int h = gw / S, s = gw % S, c = s >> 6;
    float q[128]; load_q<128>(q, QKV + O_QC + (size_t)h * HS + (size_t)s * 128);
    float m = -1e30f, l = 0.f, o0 = 0.f, o1 = 0.f;
    const bf16* Kh = QKV + O_KC + (size_t)h * HS; const bf16* Vh = QKV + O_VC + (size_t)h * HS;
    for (int t = (c >= 8 ? c - 8 : 0); t <= c; ++t) {
        const int key = 64 * t + lane; int dist = s - key; dist = dist < -256 ? -256 : (dist > 256 ? 256 : dist);
        const float sc = dot_q<128>(q, Kh + (size_t)key * 128) * 0.08838834764831845f + relb[h * 513 + dist + 256];
        osm_tile(sc, m, l, o0, o1, Vh + (size_t)(64 * t) * 128, lane);
    }
    *(unsigned*)(Y + (size_t)s * DM + 1536 + h * 128 + 2 * lane) = pk2(o0 / l, o1 / l);
}
__global__ __launch_bounds__(256) void k_attn_b(const bf16* __restrict__ QKV, const float* __restrict__ lq1, const float* __restrict__ lk1, const float* __restrict__ lq2, const float* __restrict__ lk2,
                                                const float* __restrict__ subg, double lam_init_, bf16* __restrict__ Y) {
    const float lam_init = (float)lam_init_;
    const int gw = blockIdx.x * 4 + (threadIdx.x >> 6), lane = threadIdx.x & 63; const int h = gw / S, s = gw % S, c = s >> 6;
    const float lam = expf(wave_sum(lq1[lane] * lk1[lane])) - expf(wave_sum(lq2[lane] * lk2[lane])) + lam_init;
    float q1[64], q2[64]; load_q<64>(q1, QKV + O_QB + (size_t)h * HS + (size_t)s * 128); load_q<64>(q2, QKV + O_QB + (size_t)h * HS + (size_t)s * 128 + 64);
    float m1 = -1e30f, l1 = 0.f, a0 = 0.f, a1 = 0.f, m2 = -1e30f, l2 = 0.f, b0 = 0.f, b1 = 0.f;
    const bf16* Kh = QKV + O_KB + (size_t)h * HS; const bf16* Vh = QKV + O_VB + (size_t)h * HS;
    for (int t = 0; t <= c; ++t) {
        const bf16* kr = Kh + (size_t)(64 * t + lane) * 128;
        const float s1 = dot_q<64>(q1, kr) * 0.125f, s2 = dot_q<64>(q2, kr + 64) * 0.125f;
        osm_tile(s1, m1, l1, a0, a1, Vh + (size_t)(64 * t) * 128, lane);
        osm_tile(s2, m2, l2, b0, b1, Vh + (size_t)(64 * t) * 128, lane);
    }
    const float d0 = a0 / l1 - lam * (b0 / l2), d1 = a1 / l1 - lam * (b1 / l2);
    const float r = 1.0f / sqrtf(wave_sum(d0 * d0 + d1 * d1) * (1.f / 128.f) + LN_EPS) * (1.0f - lam_init);
    *(unsigned*)(Y + (size_t)s * DM + 1024 + h * 128 + 2 * lane) = pk2(d0 * r * subg[2 * lane], d1 * r * subg[2 * lane + 1]);
}

extern "C" void kernel_launch(void* const* d_in, const int* in_sizes, int n_in, void* d_out, int out_size, void* d_ws, size_t ws_size, hipStream_t stream) {
    if (n_in != 21 || out_size != S * DM || ws_size < WS_END) { fprintf(stderr, "kernel_launch: unexpected shapes (n_in %d out %d ws %zu need %zu)\n", n_in, out_size, ws_size, (size_t)WS_END); return; }
    const float* x = (const float*)d_in[0]; const float* w_in = (const float*)d_in[1]; const float* sinks = (const float*)d_in[2];
    const float* lq1 = (const float*)d_in[3]; const float* lk1 = (const float*)d_in[4]; const float* lq2 = (const float*)d_in[5]; const float* lk2 = (const float*)d_in[6];
    const float* subg = (const float*)d_in[7]; const float* relb = (const float*)d_in[8];
    const float* w_br_a = (const float*)d_in[9]; const float* w_br_b = (const float*)d_in[10]; const float* w_br_c = (const float*)d_in[11];
    const float* w_gate = (const float*)d_in[12]; const float* b_gate = (const float*)d_in[13]; const float* w_out = (const float*)d_in[14];
    const float* ln1_g = (const float*)d_in[15]; const float* ln1_b = (const float*)d_in[16]; const float* w_f1 = (const float*)d_in[17]; const float* w_f2 = (const float*)d_in[18];
    const float* ln2_g = (const float*)d_in[19]; const float* ln2_b = (const float*)d_in[20];
    char* ws = (char*)d_ws; float* out = (float*)d_out;
    bf16* XB = (bf16*)(ws + WS_XB); bf16* QKV = (bf16*)(ws + WS_QKV); bf16* G = (bf16*)(ws + WS_G); bf16* Y = (bf16*)(ws + WS_Y); bf16* MIXB = (bf16*)(ws + WS_MIXB); bf16* F = (bf16*)(ws + WS_F);
    float* CSA = (float*)(ws + WS_CSA); float* CSB = (float*)(ws + WS_CSB); float* V32 = (float*)(ws + WS_V32); float* MIX32 = (float*)(ws + WS_MIX32); float* H32 = (float*)(ws + WS_H32);
    char* W = ws + WS_W;
    k_wcvt<<<dim3(INW / 32, DM / 64, DEPTH), 256, 0, stream>>>(w_in, (bf16*)(W + WL_W1), DM, INW, INW, 0, (size_t)DM * INW, WL_SIZE);
    k_wcvt<<<dim3(GW / 32, DM / 64, DEPTH), 256, 0, stream>>>(w_gate, (bf16*)(W + WL_W1 + (size_t)INW * DM * 2), DM, GW, GW, 0, (size_t)DM * GW, WL_SIZE);
    k_wcvt<<<dim3(DM / 32, 1024 / 64, DEPTH), 256, 0, stream>>>(w_br_a, (bf16*)(W + WL_BA), 1024, DM, DM, 0, (size_t)1024 * DM, WL_SIZE);
    k_wcvt<<<dim3(DM / 32, 512 / 64, DEPTH), 256, 0, stream>>>(w_br_b, (bf16*)(W + WL_BB), 512, DM, DM, 0, (size_t)512 * DM, WL_SIZE);
    k_wcvt<<<dim3(DM / 32, 512 / 64, DEPTH), 256, 0, stream>>>(w_br_c, (bf16*)(W + WL_BC), 512, DM, DM, 0, (size_t)512 * DM, WL_SIZE);
    k_wcvt<<<dim3(DM / 32, DM / 64, DEPTH), 256, 0, stream>>>(w_out, (bf16*)(W + WL_WO), DM, DM, DM, 0, (size_t)DM * DM, WL_SIZE);
    k_wcvt<<<dim3(2 * FH / 32, DM / 64, DEPTH), 256, 0, stream>>>(w_f1, (bf16*)(W + WL_F1), DM, 2 * FH, 2 * FH, 1, (size_t)DM * 2 * FH, WL_SIZE);
    k_wcvt<<<dim3(DM / 32, FH / 64, DEPTH), 256, 0, stream>>>(w_f2, (bf16*)(W + WL_F2), FH, DM, DM, 0, (size_t)FH * DM, WL_SIZE);
    k_xcvt<<<S * DM / 1024, 256, 0, stream>>>(x, XB);
    k_rope_tab<<<S * 96 / 256, 256, 0, stream>>>(CSA, CSB);
    for (int l = 0; l < DEPTH; ++l) {
        char* Wl = W + (size_t)l * WL_SIZE; const float* xres = l == 0 ? x : out;
        const double lam_init = (double)(float)(0.8 - 0.6 * exp(-0.3 * (double)l));
        k_gemm<EpiH32><<<dim3(INW / 128, S / 128), 256, 0, stream>>>(XB, DM, (const bf16*)(Wl + WL_W1), DM, EpiH32{H32, INW});
        k_rope_split<<<S, 256, 0, stream>>>(H32, QKV, CSA, CSB);
        k_gemm<EpiGate><<<dim3(GW / 128, S / 128), 256, 0, stream>>>(XB, DM, (const bf16*)(Wl + WL_W1 + (size_t)INW * DM * 2), DM, EpiGate{G, b_gate + (size_t)l * GW});
        k_attn_a<<<8 * S / 4, 256, 0, stream>>>(QKV, sinks + l * 8, Y);
        k_attn_b<<<4 * S / 4, 256, 0, stream>>>(QKV, lq1 + l * 64, lk1 + l * 64, lq2 + l * 64, lk2 + l * 64, subg + l * 128, lam_init, Y);
        k_attn_c<<<4 * S / 4, 256, 0, stream>>>(QKV, relb + (size_t)l * 4 * 513, Y);
        k_gemm<EpiBr<0>><<<dim3(DM / 128, S / 128), 256, 0, stream>>>(Y, DM, (const bf16*)(Wl + WL_BA), 1024, EpiBr<0>{G, 0, MIX32, MIXB});
        k_gemm<EpiBr<1>><<<dim3(DM / 128, S / 128), 256, 0, stream>>>(Y + 1024, DM, (const bf16*)(Wl + WL_BB), 512, EpiBr<1>{G, 2048, MIX32, MIXB});
        k_gemm<EpiBr<2>><<<dim3(DM / 128, S / 128), 256, 0, stream>>>(Y + 1536, DM, (const bf16*)(Wl + WL_BC), 512, EpiBr<2>{G, 4096, MIX32, MIXB});
        k_gemm<EpiRes><<<dim3(DM / 128, S / 128), 256, 0, stream>>>(MIXB, DM, (const bf16*)(Wl + WL_WO), DM, EpiRes{xres, V32});
        k_ln<<<S / 4, 256, 0, stream>>>(V32, ln1_g + (size_t)l * DM, ln1_b + (size_t)l * DM, out, XB);
        k_gemm<EpiSwiGLU><<<dim3(2 * FH / 128, S / 128), 256, 0, stream>>>(XB, DM, (const bf16*)(Wl + WL_F1), DM, EpiSwiGLU{F});
        k_gemm<EpiRes><<<dim3(DM / 128, S / 128), 256, 0, stream>>>(F, FH, (const bf16*)(Wl + WL_F2), FH, EpiRes{out, V32});
        k_ln<<<S / 4, 256, 0, stream>>>(V32, ln2_g + (size_t)l * DM, ln2_b + (size_t)l * DM, out, XB);
    }
}
```

```cpp
#include <hip/hip_runtime.h>
#include <cstdio>
#include <cstdint>
#include <cmath>

namespace pg8 {
#define PG8_LAS __attribute__((address_space(3)))
typedef unsigned short bf16_t;
typedef short bf16x8 __attribute__((ext_vector_type(8)));
typedef float f32x4 __attribute__((ext_vector_type(4)));
typedef unsigned u32x4 __attribute__((ext_vector_type(4)));
typedef unsigned u32x2 __attribute__((ext_vector_type(2)));
constexpr int BM = 256, BK = 64, HALF = 128, HTB = HALF * BK * 2  , STAGE_BYTES = 8 * HTB, NXCD = 8, WGM = 8;

__host__ __device__ __forceinline__ int lds_byte(int r, int c) { const int st = (r >> 4) * 2 + (c >> 5), rr = r & 15, cc = c & 31, ob = rr * 64 + cc * 2; return st * 1024 + (ob ^ (((ob >> 9) & 1) << 5)); }
__host__ __device__ __forceinline__ void stage_rc(int b, int& R, int& C) { const int st = b / 1024, sb = b % 1024, swz = sb ^ (((sb >> 9) & 1) << 5); R = (st >> 1) * 16 + swz / 64; C = (st & 1) * 32 + (swz % 64) / 2; }

struct Unit { int pm, pn; };
struct Gemm { const bf16_t* A; const bf16_t* Bt; int lda, K; };

struct StaticOrder {
    int nM, nN, nwg, G, c;
    __host__ __device__ void init(int M, int N, int G_, int c_) { nM = M / BM; nN = N / BM; nwg = nM * nN; G = G_; c = c_; }
    __host__ __device__ bool next(int i, Unit& u) const {
        const long L = (long)i * G + c; if (L >= nwg) return false;
        int wgid = (int)L; { const int q = nwg / NXCD, r = nwg % NXCD, xcd = wgid % NXCD, off = wgid / NXCD; wgid = (xcd < r ? xcd * (q + 1) : r * (q + 1) + (xcd - r) * q) + off; }
        const int nig = WGM * nN, gid = wgid / nig, fm = gid * WGM, gsz = (nM - fm) < WGM ? (nM - fm) : WGM;
        u.pm = fm + ((wgid % nig) % gsz); u.pn = (wgid % nig) / gsz; return true;
    }
    __device__ __forceinline__ void a_ready(const Unit&) const {}
    __device__ __forceinline__ void done(const Unit&) const {}
};

template <class Epi, class Sched, bool ALIGN_EPI>
__device__ __forceinline__ void gemm_phase(PG8_LAS unsigned char* lds, const Gemm g, const Sched& S, const Epi& E) {
    int tid_ = threadIdx.x; asm volatile("" : "+v"(tid_));
    const int tid = tid_, wid = __builtin_amdgcn_readfirstlane(tid >> 6), lane = tid & 63, wr = wid >> 2, wc = wid & 3, fr = lane & 15, fq = lane >> 4;
    const int K = g.K, lda = g.lda, nt = K / BK;
    unsigned voffA[2], voffB[2];
#pragma unroll
    for (int i = 0; i < 2; ++i) { int R, C; stage_rc(tid * 16 + i * 8192, R, C);
        voffA[i] = (unsigned)(R * lda + C) * 2u; voffB[i] = (unsigned)(R * K + C) * 2u; }
    const size_t kstep = (size_t)(BK * 2);
    const size_t hstepA = (size_t)HALF * lda * 2, hstepB = (size_t)HALF * K * 2;
    const size_t tstepA = 2 * hstepA, tstepB = 2 * hstepB;
    const unsigned ldsw = (unsigned)wid * 1024u;
    const int aoff = lds_byte(wr * 64 + fr, fq * 8), boff = lds_byte(wc * 32 + fr, fq * 8);
#define PG8_SA(b, h) (((b) * 2 + (h)) * HTB)
#define PG8_SB(b, h) ((4 + (b) * 2 + (h)) * HTB)
#define PG8_STAGE(bufoff, gbase, voff) do { _Pragma("unroll") for (int _i = 0; _i < 2; ++_i) \
        __builtin_amdgcn_global_load_lds((const unsigned*)((const char*)(gbase) + (voff)[_i]), (PG8_LAS unsigned*)(lds + (bufoff) + ldsw + _i * 8192), 16, 0, 0); } while (0)
#define PG8_LDA(dst, b, h) do { _Pragma("unroll") for (int m = 0; m < 4; ++m) _Pragma("unroll") for (int k = 0; k < 2; ++k) dst[m][k] = *(const PG8_LAS bf16x8*)(lds + PG8_SA(b, h) + aoff + m * 2048 + k * 1024); } while (0)
#define PG8_LDB(dst, b, h) do { _Pragma("unroll") for (int n = 0; n < 2; ++n) _Pragma("unroll") for (int k = 0; k < 2; ++k) dst[n][k] = *(const PG8_LAS bf16x8*)(lds + PG8_SB(b, h) + boff + n * 2048 + k * 1024); } while (0)
#define PG8_MMA(ai, bj, At, Bt) do { __builtin_amdgcn_s_setprio(1); _Pragma("unroll") for (int m = 0; m < 4; ++m) _Pragma("unroll") for (int n = 0; n < 2; ++n) _Pragma("unroll") for (int k = 0; k < 2; ++k) \
        acc[ai][bj][m][n] = __builtin_amdgcn_mfma_f32_16x16x32_bf16(Bt[n][k], At[m][k], acc[ai][bj][m][n], 0, 0, 0); __builtin_amdgcn_s_setprio(0); } while (0)
#define PG8_WAIT_V(n) asm volatile("s_waitcnt vmcnt(" #n ")" ::: "memory")
#define PG8_WAIT_L(n) asm volatile("s_waitcnt lgkmcnt(" #n ")" ::: "memory")
#define PG8_BAR __builtin_amdgcn_s_barrier()
#define PG8_SCHED __builtin_amdgcn_sched_barrier(0)
    Unit cur, nxt; int ui = 0;
    if (!S.next(0, cur)) return;
    f32x4 acc[2][2][4][2];
#pragma unroll
    for (int a = 0; a < 2; ++a)
#pragma unroll
        for (int b = 0; b < 2; ++b)
#pragma unroll
            for (int m = 0; m < 4; ++m)
#pragma unroll
                for (int n = 0; n < 2; ++n) acc[a][b][m][n] = (f32x4){0.f, 0.f, 0.f, 0.f};
    bf16x8 At[4][2], B0[2][2], B1[2][2];
    const char* cA = (const char*)g.A + (size_t)cur.pm * tstepA; const char* cB = (const char*)g.Bt + (size_t)cur.pn * tstepB;
    S.a_ready(cur);
    PG8_STAGE(PG8_SB(0, 0), cB, voffB); PG8_STAGE(PG8_SB(0, 1), cB + hstepB, voffB); PG8_STAGE(PG8_SA(0, 0), cA, voffA); PG8_STAGE(PG8_SA(0, 1), cA + hstepA, voffA);
    if (wr == 1) PG8_BAR;
    PG8_WAIT_V(2); PG8_BAR;
    PG8_STAGE(PG8_SB(1, 0), cB + kstep, voffB); PG8_STAGE(PG8_SA(1, 0), cA + kstep, voffA); PG8_STAGE(PG8_SB(1, 1), cB + hstepB + kstep, voffB);
    PG8_WAIT_V(6); PG8_BAR;
    for (;;) {
        const bool has_next = S.next(ui + 1, nxt);
        const char* nA = has_next ? (const char*)g.A + (size_t)nxt.pm * tstepA : cA; const char* nB = has_next ? (const char*)g.Bt + (size_t)nxt.pn * tstepB : cB;
        for (int t = 0; t < nt; t += 2) {
            const bool last = (t == nt - 2);
            const char* a1 = cA + (size_t)(t + 1) * kstep;
            const char* a2 = last ? nA : cA + (size_t)(t + 2) * kstep; const char* b2 = last ? nB : cB + (size_t)(t + 2) * kstep;
            const char* a3 = a2 + kstep; const char* b3 = b2 + kstep;
            if (last && has_next) S.a_ready(nxt);
            PG8_LDB(B0, 0, 0); PG8_LDB(B1, 0, 1); PG8_SCHED; PG8_LDA(At, 0, 0); PG8_STAGE(PG8_SA(1, 1), a1 + hstepA, voffA);
            PG8_WAIT_V(8); PG8_WAIT_L(0); PG8_BAR; PG8_MMA(0, 0, At, B0); PG8_MMA(0, 1, At, B1); PG8_BAR; PG8_SCHED;
            PG8_LDA(At, 0, 1); PG8_STAGE(PG8_SB(0, 0), b2, voffB); PG8_STAGE(PG8_SB(0, 1), b2 + hstepB, voffB); PG8_STAGE(PG8_SA(0, 0), a2, voffA);
            PG8_WAIT_V(8); PG8_WAIT_L(0); PG8_BAR; PG8_MMA(1, 0, At, B0); PG8_MMA(1, 1, At, B1); PG8_BAR; PG8_SCHED;
            PG8_LDB(B0, 1, 0); PG8_LDB(B1, 1, 1); PG8_SCHED; PG8_LDA(At, 1, 0); PG8_STAGE(PG8_SA(0, 1), a2 + hstepA, voffA);
            PG8_WAIT_V(8); PG8_WAIT_L(0); PG8_BAR; PG8_MMA(0, 0, At, B0); PG8_MMA(0, 1, At, B1); PG8_BAR; PG8_SCHED;
            PG8_LDA(At, 1, 1); PG8_STAGE(PG8_SB(1, 0), b3, voffB); PG8_STAGE(PG8_SB(1, 1), b3 + hstepB, voffB); PG8_STAGE(PG8_SA(1, 0), a3, voffA);
            PG8_WAIT_V(8); PG8_WAIT_L(0); PG8_BAR; PG8_MMA(1, 0, At, B0); PG8_MMA(1, 1, At, B1); PG8_BAR; PG8_SCHED;
        }
        if constexpr (ALIGN_EPI) { if (wr == 0) PG8_BAR; }
        E(acc, cur, wr, wc, fr, fq); S.done(cur);
        if (!has_next) break;
#pragma unroll
        for (int a = 0; a < 2; ++a)
#pragma unroll
            for (int b = 0; b < 2; ++b)
#pragma unroll
                for (int m = 0; m < 4; ++m)
#pragma unroll
                    for (int n = 0; n < 2; ++n) acc[a][b][m][n] = (f32x4){0.f, 0.f, 0.f, 0.f};
        cur = nxt; cA = nA; cB = nB; ++ui;
        if constexpr (ALIGN_EPI) { if (wr == 1) PG8_BAR; }
    }
    PG8_WAIT_V(0);
    if constexpr (!ALIGN_EPI) { if (wr == 0) PG8_BAR; }
    PG8_BAR;
#undef PG8_SA
#undef PG8_SB
#undef PG8_STAGE
#undef PG8_LDA
#undef PG8_LDB
#undef PG8_MMA
#undef PG8_WAIT_V
#undef PG8_WAIT_L
#undef PG8_BAR
#undef PG8_SCHED
}
}

typedef unsigned short bf16;
typedef short bf16x8 __attribute__((ext_vector_type(8)));
typedef float f32x4 __attribute__((ext_vector_type(4)));
typedef float f32x2 __attribute__((ext_vector_type(2)));
typedef unsigned u32x4 __attribute__((ext_vector_type(4)));
typedef unsigned u32x2 __attribute__((ext_vector_type(2)));
#define GAS __attribute__((address_space(1)))
#define LAS __attribute__((address_space(3)))
typedef GAS unsigned gu32;

constexpr int S = 8192, DM = 2048, DEPTH = 4, INW = 4608, GW = 6144, FH = 5632;
constexpr float LN_EPS = 1e-5f;
constexpr float ALPHA = 1.6817928305074290f;
constexpr float LOG2E = 1.4426950408889634f;
constexpr size_t MiB = 1u << 20;
constexpr int NWAVES = 8;

constexpr size_t WL_W1 = 0;
constexpr size_t WL_BA = WL_W1 + (size_t)10752 * 2048 * 2;
constexpr size_t WL_BB = WL_BA + (size_t)2048 * 1024 * 2;
constexpr size_t WL_BC = WL_BB + (size_t)2048 * 512 * 2;
constexpr size_t WL_WO = WL_BC + (size_t)2048 * 512 * 2;
constexpr size_t WL_F1 = WL_WO + (size_t)2048 * 2048 * 2;
constexpr size_t WL_F2 = WL_F1 + (size_t)11264 * 2048 * 2;
constexpr size_t WL_SIZE = WL_F2 + (size_t)2048 * 5632 * 2;
constexpr size_t WS_CTL = 0, CTL_ZERO_BYTES = 1 * MiB;
constexpr size_t WS_W = 1 * MiB;
constexpr size_t WS_XB = WS_W + 4 * WL_SIZE;
constexpr size_t WS_QKV = WS_XB + (size_t)S * DM * 2;
constexpr size_t WS_G = WS_QKV + (size_t)S * INW * 2;
constexpr size_t WS_Y = WS_G + (size_t)S * GW * 2;
constexpr size_t WS_MIXB = WS_Y + (size_t)S * DM * 2;
constexpr size_t WS_F = WS_MIXB + (size_t)S * DM * 2;
constexpr size_t WS_CSA = WS_F + (size_t)S * FH * 2;
constexpr size_t WS_CSB = WS_CSA + (size_t)S * 64 * 2 * 4;
constexpr size_t WS_V32 = WS_CSB + (size_t)S * 32 * 2 * 4;
constexpr size_t WS_MIX32 = WS_V32 + (size_t)S * DM * 4;
constexpr size_t WS_END = WS_MIX32 + (size_t)S * DM * 4;
constexpr size_t HS = (size_t)S * 128;
constexpr size_t O_QA = 0, O_KA = 8 * HS, O_VA = 10 * HS, O_QB = 12 * HS, O_KB = 16 * HS, O_VB = 20 * HS, O_QC = 24 * HS, O_KC = 28 * HS, O_VC = 32 * HS;
constexpr int CW_BAR = 4096;
constexpr int RING_BYTES = 131072, LDSCTL_OFF = RING_BYTES, MISC_OFF = LDSCTL_OFF + 320, LDS_BYTES = 147456;

__device__ __forceinline__ unsigned f2bf(float f) { unsigned u = __builtin_bit_cast(unsigned, f); return (u + 0x7fffu + ((u >> 16) & 1u)) >> 16; }
__device__ __forceinline__ unsigned pk2(float lo, float hi) { return f2bf(lo) | (f2bf(hi) << 16); }
__device__ __forceinline__ float bf2f(unsigned short b) { return __builtin_bit_cast(float, (unsigned)b << 16); }
__device__ __forceinline__ u32x2 pk4(f32x4 v) { u32x2 o; o.x = pk2(v[0], v[1]); o.y = pk2(v[2], v[3]); return o; }
__device__ __forceinline__ f32x4 unpk4(u32x2 w) { f32x4 g; g[0] = bf2f(w.x & 0xffff); g[1] = bf2f(w.x >> 16); g[2] = bf2f(w.y & 0xffff); g[3] = bf2f(w.y >> 16); return g; }
__device__ __forceinline__ float wave_sum(float v) {
#pragma unroll
    for (int o = 1; o < 64; o <<= 1) v += __shfl_xor(v, o);
    return v;
}
__device__ __forceinline__ float wave_max(float v) {
#pragma unroll
    for (int o = 1; o < 64; o <<= 1) v = fmaxf(v, __shfl_xor(v, o));
    return v;
}
__device__ __forceinline__ float fsigmoid(float z) { return __builtin_amdgcn_rcpf(1.0f + __builtin_amdgcn_exp2f(-z * LOG2E)); }

#define XB_TMO      128
#define XB_XCNT(j)  (256  + 64 * (j))
#define XB_XSUB(j)  (1280 + 64 * (j))
#define XB_XGEN(j)  (2304 + 64 * (j))
#define XB_TOP      3328
#define XB_TOPGEN   3392
#define XCD_BAR_WORDS 3456
#define XB_SPIN_CAP (1u << 18)
__device__ __forceinline__ unsigned xb_ld(unsigned* p)              { return __hip_atomic_load(p, __ATOMIC_RELAXED, __HIP_MEMORY_SCOPE_AGENT); }
__device__ __forceinline__ unsigned xb_add(unsigned* p, unsigned v) { return __hip_atomic_fetch_add(p, v, __ATOMIC_RELAXED, __HIP_MEMORY_SCOPE_AGENT); }
__device__ __forceinline__ unsigned xb_xcc_id() { return (unsigned)__builtin_amdgcn_s_getreg((3 << 11) | 20) & 0xFu; }
#define XB_SPIN(cond, bar) do { unsigned _sp = 0; while (cond) { __builtin_amdgcn_s_sleep(1); \
    if ((++_sp & 255u) == 0u) { if (xb_ld(&(bar)[XB_TMO])) break; if (_sp > XB_SPIN_CAP) { atomicAdd(&(bar)[XB_TMO], 1u); break; } } } } while (0)
struct XcdBarrier { unsigned* bar; unsigned x; volatile LAS unsigned* st; };
__device__ __forceinline__ XcdBarrier xcd_barrier_post(unsigned* bar, volatile LAS unsigned* st) {
    XcdBarrier b; b.bar = bar; b.x = xb_xcc_id(); b.st = st;
    if (threadIdx.x == 0) (void)xb_add(&bar[XB_XCNT(b.x)], 1u);
    return b;
}
__device__ __forceinline__ void xcd_barrier_complete(unsigned* bar, unsigned x, unsigned& nloc, unsigned& nx) {
    const unsigned G = gridDim.x * gridDim.y * gridDim.z;
    unsigned sum, cnt, mine, sp = 0u;
    for (;;) {
        sum = 0u; cnt = 0u; mine = 0u;
#pragma unroll
        for (unsigned j = 0; j < 16; ++j) { const unsigned c = xb_ld(&bar[XB_XCNT(j)]); sum += c; cnt += (c > 0u) ? 1u : 0u; mine = (j == x) ? c : mine; }
        if (sum == G) break;
        __builtin_amdgcn_s_sleep(1);
        if ((++sp & 255u) == 0u) { if (xb_ld(&bar[XB_TMO])) break; if (sp > XB_SPIN_CAP) { atomicAdd(&bar[XB_TMO], 1u); break; } }
    }
    nloc = mine > 0u ? mine : 1u; nx = cnt > 0u ? cnt : 1u;
}
template <bool FIRST>
__device__ __forceinline__ void xcd_barrier_t(const XcdBarrier& b) {
    asm volatile("s_waitcnt vmcnt(0)" ::: "memory");
    __syncthreads();
    if (threadIdx.x == 0) {
        GAS unsigned* barg = (GAS unsigned*)b.bar; unsigned x = b.x;
        asm volatile("" : "+s"(barg), "+s"(x)); unsigned* bar = (unsigned*)barg;
        __builtin_amdgcn_s_waitcnt(0);
        unsigned nloc = b.st[0], nx = b.st[1];
        if (FIRST) { if (nloc == 0u) { xcd_barrier_complete(bar, x, nloc, nx); b.st[0] = nloc; b.st[1] = nx; } }
        else { nloc = nloc ? nloc : 1u; nx = nx ? nx : 1u; }
        const unsigned old = xb_add(&bar[XB_XSUB(x)], 1u);
        const unsigned gen = old / nloc;
        if (old + 1u == (gen + 1u) * nloc) {
            __builtin_amdgcn_fence(__ATOMIC_RELEASE, "agent");
            asm volatile("s_waitcnt vmcnt(0)" ::: "memory");
            const unsigned og = xb_add(&bar[XB_TOP], 1u);
            const unsigned tg = og / nx;
            if (og + 1u == (tg + 1u) * nx) xb_add(&bar[XB_TOPGEN], 1u);
            else XB_SPIN(xb_ld(&bar[XB_TOPGEN]) == tg, bar);
            __builtin_amdgcn_fence(__ATOMIC_ACQUIRE, "agent");
            xb_add(&bar[XB_XGEN(x)], 1u);
            asm volatile("s_waitcnt vmcnt(0)" ::: "memory");
        } else {
            XB_SPIN(xb_ld(&bar[XB_XGEN(x)]) == gen, bar);
            __builtin_amdgcn_fence(__ATOMIC_ACQUIRE, "agent");
            asm volatile("s_waitcnt vmcnt(0)" ::: "memory");
        }
    }
    __syncthreads();
}

using pg8::Unit;
struct EpiIn { bf16* QKV; const float* csa; const float* csb;
    static constexpr bool PERM = false;
    __device__ __forceinline__ void operator()(const f32x4 (&acc)[2][2][4][2], const Unit& u, int wr, int wc, int fr, int fq) const {
#pragma unroll
        for (int bj = 0; bj < 2; ++bj) { const int hh = u.pn * 2 + bj; bf16* hb = QKV + (size_t)hh * HS;
            if (hh < 10) {
                const int d0 = 16 * wc + 4 * fq;
#pragma unroll
                for (int ai = 0; ai < 2; ++ai)
#pragma unroll
                    for (int m = 0; m < 4; ++m) { const int s = u.pm * 256 + ai * 128 + wr * 64 + m * 16 + fr; const f32x4 x0 = acc[ai][bj][m][0], x1 = acc[ai][bj][m][1];
                        const f32x4 cs0 = *(const f32x4*)(csa + ((size_t)s * 64 + d0) * 2), cs1 = *(const f32x4*)(csa + ((size_t)s * 64 + d0) * 2 + 4);
                        const f32x4 c = {cs0[0], cs0[2], cs1[0], cs1[2]}, sn = {cs0[1], cs0[3], cs1[1], cs1[3]};
                        const f32x4 o0 = x0 * c - x1 * sn, o1 = x1 * c + x0 * sn;
                        *(u32x2*)(hb + (size_t)s * 128 + d0) = pk4(o0); *(u32x2*)(hb + (size_t)s * 128 + d0 + 64) = pk4(o1); }
            } else if (hh >= 12 && hh < 20) {
                const int dd = 16 * (wc & 1) + 4 * fq, cb = 64 * (wc >> 1);
#pragma unroll
                for (int ai = 0; ai < 2; ++ai)
#pragma unroll
                    for (int m = 0; m < 4; ++m) { const int s = u.pm * 256 + ai * 128 + wr * 64 + m * 16 + fr; const f32x4 x0 = acc[ai][bj][m][0], x1 = acc[ai][bj][m][1];
                        const f32x4 cs0 = *(const f32x4*)(csb + ((size_t)s * 32 + dd) * 2), cs1 = *(const f32x4*)(csb + ((size_t)s * 32 + dd) * 2 + 4);
                        const f32x4 c = {cs0[0], cs0[2], cs1[0], cs1[2]}, sn = {cs0[1], cs0[3], cs1[1], cs1[3]};
                        const f32x4 o0 = x0 * c - x1 * sn, o1 = x1 * c + x0 * sn;
                        *(u32x2*)(hb + (size_t)s * 128 + cb + dd) = pk4(o0); *(u32x2*)(hb + (size_t)s * 128 + cb + dd + 32) = pk4(o1); }
            } else {
                const int d0 = 32 * wc + 4 * fq;
#pragma unroll
                for (int ai = 0; ai < 2; ++ai)
#pragma unroll
                    for (int m = 0; m < 4; ++m) { const int s = u.pm * 256 + ai * 128 + wr * 64 + m * 16 + fr;
                        *(u32x2*)(hb + (size_t)s * 128 + d0) = pk4(acc[ai][bj][m][0]); *(u32x2*)(hb + (size_t)s * 128 + d0 + 16) = pk4(acc[ai][bj][m][1]); }
            }
        }
    }
};
struct EpiGate { bf16* G; const float* bias;
    static constexpr bool PERM = false;
    __device__ __forceinline__ void operator()(const f32x4 (&acc)[2][2][4][2], const Unit& u, int wr, int wc, int fr, int fq) const {
#pragma unroll
        for (int bj = 0; bj < 2; ++bj)
#pragma unroll
            for (int n = 0; n < 2; ++n) { const int col = u.pn * 256 + bj * 128 + wc * 32 + n * 16 + 4 * fq; const f32x4 b = *(const f32x4*)(bias + col);
#pragma unroll
                for (int ai = 0; ai < 2; ++ai)
#pragma unroll
                    for (int m = 0; m < 4; ++m) { const int s = u.pm * 256 + ai * 128 + wr * 64 + m * 16 + fr; f32x4 v = acc[ai][bj][m][n] + b;
#pragma unroll
                        for (int r = 0; r < 4; ++r) v[r] = fsigmoid(v[r]);
                        *(u32x2*)(G + (size_t)s * GW + col) = pk4(v); } }
    }
};
template <int MODE> struct EpiBr { const bf16* G; int goff, pad; float* MIX32; bf16* MIXB;
    static constexpr bool PERM = false;
    __device__ __forceinline__ void operator()(const f32x4 (&acc)[2][2][4][2], const Unit& u, int wr, int wc, int fr, int fq) const {
#pragma unroll
        for (int ai = 0; ai < 2; ++ai)
#pragma unroll
            for (int m = 0; m < 4; ++m) { const int s = u.pm * 256 + ai * 128 + wr * 64 + m * 16 + fr;
#pragma unroll
                for (int bj = 0; bj < 2; ++bj)
#pragma unroll
                    for (int n = 0; n < 2; ++n) { const int col = u.pn * 256 + bj * 128 + wc * 32 + n * 16 + 4 * fq;
                        const f32x4 g = unpk4(*(const u32x2*)(G + (size_t)s * GW + goff + col)); f32x4 v = acc[ai][bj][m][n] * g; float* mp = MIX32 + (size_t)s * DM + col;
                        if (MODE >= 1) v += *(const f32x4*)mp;
                        if (MODE <= 1) *(f32x4*)mp = v; else *(u32x2*)(MIXB + (size_t)s * DM + col) = pk4(v); } }
    }
};
struct EpiRes { const float* xres; float* V32;
    static constexpr bool PERM = false;
    __device__ __forceinline__ void operator()(const f32x4 (&acc)[2][2][4][2], const Unit& u, int wr, int wc, int fr, int fq) const {
#pragma unroll
        for (int ai = 0; ai < 2; ++ai)
#pragma unroll
            for (int m = 0; m < 4; ++m) { const int s = u.pm * 256 + ai * 128 + wr * 64 + m * 16 + fr;
#pragma unroll
                for (int bj = 0; bj < 2; ++bj)
#pragma unroll
                    for (int n = 0; n < 2; ++n) { const size_t off = (size_t)s * DM + u.pn * 256 + bj * 128 + wc * 32 + n * 16 + 4 * fq;
                        *(f32x4*)(V32 + off) = *(const f32x4*)(xres + off) * ALPHA + acc[ai][bj][m][n]; } }
    }
};
struct EpiSwiGLU { bf16* F;
    static constexpr bool PERM = false;
    __device__ __forceinline__ void operator()(const f32x4 (&acc)[2][2][4][2], const Unit& u, int wr, int wc, int fr, int fq) const {
#pragma unroll
        for (int ai = 0; ai < 2; ++ai)
#pragma unroll
            for (int m = 0; m < 4; ++m) { const int s = u.pm * 256 + ai * 128 + wr * 64 + m * 16 + fr;
#pragma unroll
                for (int bj = 0; bj < 2; ++bj) { const f32x4 g = acc[ai][bj][m][0], up = acc[ai][bj][m][1]; f32x4 v;
#pragma unroll
                    for (int r = 0; r < 4; ++r) v[r] = g[r] * fsigmoid(g[r]) * up[r];
                    *(u32x2*)(F + (size_t)s * FH + u.pn * 128 + bj * 64 + wc * 16 + 4 * fq) = pk4(v); } }
    }
};

struct Args { const float* in[21]; float* out; unsigned char* ws; };
struct Frame {
    LAS unsigned char* lds; volatile LAS unsigned* MISC; gu32* ctl;
    int tid, lane, wave, vcu, G;
};

__device__ __forceinline__ int colmap(int kind, int nb) {
    if (kind == 1) return ((nb & 1) ? FH : 0) + (nb >> 1) * 16;
    if (kind == 2) { const int hh = nb >> 3, blk = nb & 7, wc = blk >> 1, n = blk & 1;
        if (hh < 10) return hh * 128 + 16 * wc + 64 * n;
        if (hh >= 12 && hh < 20) return hh * 128 + 64 * (wc >> 1) + 16 * (wc & 1) + 32 * n;
        return nb * 16; }
    return nb * 16;
}
__device__ __forceinline__ void p0_transpose_item(const float* W, int K, int Nsrc, int kind, bf16* WT, LAS float* scr, int item, int nblk, int lane) {
    const int kb = item / nblk, nb = item % nblk, k0 = 64 * kb, n0 = 32 * nb;
    const int scol = colmap(kind, 2 * nb + ((lane >> 4) & 1)) + (lane & 15);
#pragma unroll 8
    for (int i = 0; i < 32; ++i) { const int kk = 2 * i + (lane >> 5); scr[kk * 33 + (lane & 31)] = W[(size_t)(k0 + kk) * Nsrc + scol]; }
    asm volatile("s_waitcnt lgkmcnt(0)" ::: "memory");
    const int c = lane & 7;
#pragma unroll
    for (int j = 0; j < 4; ++j) { const int n = (lane >> 3) + 8 * j; const LAS float* s = scr + (8 * c) * 33 + n;
        u32x4 o; o.x = pk2(s[0 * 33], s[1 * 33]); o.y = pk2(s[2 * 33], s[3 * 33]); o.z = pk2(s[4 * 33], s[5 * 33]); o.w = pk2(s[6 * 33], s[7 * 33]);
        *(GAS u32x4*)(WT + (size_t)(n0 + n) * K + k0 + 8 * c) = o; }
    asm volatile("s_waitcnt lgkmcnt(0)" ::: "memory");
}
struct WDesc { int src, K, Nsrc, Ndst, kind; size_t dst; };
__device__ __forceinline__ void p0_prologue(Frame& F, const Args& a) {
    LAS float* scr = (LAS float*)(F.lds + F.wave * 16384);
    const int gw = F.vcu * NWAVES + F.wave, NGW = F.G * NWAVES;
    unsigned char* ws = a.ws;
#define WCVT(SRC, K_, NSRC, NDST, KIND, DSTOFF) do { const int nblk = (NDST) / 32, nit = ((K_) / 64) * nblk; \
        for (int l = 0; l < DEPTH; ++l) { const float* Wl = a.in[SRC] + (size_t)l * (K_) * (NSRC); bf16* WTl = (bf16*)(ws + WS_W + (size_t)l * WL_SIZE + (DSTOFF)); \
            for (int it = gw; it < nit; it += NGW) p0_transpose_item(Wl, (K_), (NSRC), (KIND), WTl, scr, it, nblk, F.lane); } } while (0)
    WCVT(1, DM, INW, INW, 2, WL_W1);
    WCVT(12, DM, GW, GW, 0, WL_W1 + (size_t)INW * DM * 2);
    WCVT(9, 1024, DM, DM, 0, WL_BA);
    WCVT(10, 512, DM, DM, 0, WL_BB);
    WCVT(11, 512, DM, DM, 0, WL_BC);
    WCVT(14, DM, DM, DM, 0, WL_WO);
    WCVT(17, DM, 2 * FH, 2 * FH, 1, WL_F1);
    WCVT(18, FH, DM, DM, 0, WL_F2);
#undef WCVT
    { const float* x = a.in[0]; bf16* xb = (bf16*)(ws + WS_XB);
        for (size_t i = ((size_t)blockIdx.x * 512 + F.tid) * 4; i < (size_t)S * DM; i += (size_t)F.G * 512 * 4) *(u32x2*)(xb + i) = pk4(*(const f32x4*)(x + i)); }
    { float* csa = (float*)(ws + WS_CSA); float* csb = (float*)(ws + WS_CSB);
        for (int idx = blockIdx.x * 512 + F.tid; idx < S * 96; idx += F.G * 512) { const int s = idx / 96, j = idx % 96;
            if (j < 64) { const float e = (float)(2 * j) / 128.0f; const float inv = 1.0f / powf(10000.0f, e); const float ang = (float)s * inv;
                csa[((size_t)s * 64 + j) * 2] = (float)cos((double)ang); csa[((size_t)s * 64 + j) * 2 + 1] = (float)sin((double)ang); }
            else { const int i = j - 64; const float e = (float)(2 * i) / 64.0f; const float inv = 1.0f / powf(10000.0f, e); const float ang = (float)s * inv;
                csb[((size_t)s * 32 + i) * 2] = (float)cos((double)ang); csb[((size_t)s * 32 + i) * 2 + 1] = (float)sin((double)ang); } } }
}

__device__ __forceinline__ void ln_phase(Frame& F, const float* V, const float* g, const float* b, float* xo, bf16* xb) {
    int lane_ = F.lane; asm volatile("" : "+v"(lane_));
    const int gw = F.vcu * NWAVES + F.wave, NGW = F.G * NWAVES, lane = lane_;
    for (int row = gw; row < S; row += NGW) {
        const f32x4* vr = (const f32x4*)(V + (size_t)row * DM) + lane;
        f32x4 v[8]; float s = 0.f;
#pragma unroll
        for (int j = 0; j < 8; ++j) { v[j] = vr[64 * j]; s += (v[j][0] + v[j][1]) + (v[j][2] + v[j][3]); }
        const float mean = wave_sum(s) * (1.f / DM); float q = 0.f;
#pragma unroll
        for (int j = 0; j < 8; ++j) { v[j] = v[j] - mean; q += (v[j][0] * v[j][0] + v[j][1] * v[j][1]) + (v[j][2] * v[j][2] + v[j][3] * v[j][3]); }
        const float rstd = 1.0f / sqrtf(wave_sum(q) * (1.f / DM) + LN_EPS);
#pragma unroll
        for (int j = 0; j < 8; ++j) { const int col = 4 * lane + 256 * j; const f32x4 gg = *(const f32x4*)(g + col), bb = *(const f32x4*)(b + col);
            const f32x4 y = v[j] * rstd * gg + bb; *(f32x4*)(xo + (size_t)row * DM + col) = y; *(u32x2*)(xb + (size_t)row * DM + col) = pk4(y); }
    }
}

template <int N> __device__ __forceinline__ void load_q(float (&q)[N], const bf16* p) {
#pragma unroll
    for (int i = 0; i < N / 8; ++i) { const u32x4 w = *(const u32x4*)(p + 8 * i);
        q[8 * i + 0] = bf2f(w.x & 0xffff); q[8 * i + 1] = bf2f(w.x >> 16); q[8 * i + 2] = bf2f(w.y & 0xffff); q[8 * i + 3] = bf2f(w.y >> 16);
        q[8 * i + 4] = bf2f(w.z & 0xffff); q[8 * i + 5] = bf2f(w.z >> 16); q[8 * i + 6] = bf2f(w.w & 0xffff); q[8 * i + 7] = bf2f(w.w >> 16); }
}
template <int N> __device__ __forceinline__ float dot_q(const float (&q)[N], const bf16* p) {
    float a = 0.f;
#pragma unroll
    for (int i = 0; i < N / 8; ++i) { const u32x4 w = *(const u32x4*)(p + 8 * i);
        a += q[8 * i + 0] * bf2f(w.x & 0xffff); a += q[8 * i + 1] * bf2f(w.x >> 16); a += q[8 * i + 2] * bf2f(w.y & 0xffff); a += q[8 * i + 3] * bf2f(w.y >> 16);
        a += q[8 * i + 4] * bf2f(w.z & 0xffff); a += q[8 * i + 5] * bf2f(w.z >> 16); a += q[8 * i + 6] * bf2f(w.w & 0xffff); a += q[8 * i + 7] * bf2f(w.w >> 16); }
    return a;
}
__device__ __forceinline__ void osm_tile(float sc, float& m, float& l, float& o0, float& o1, const bf16* Vt, int lane) {
    const float tm = wave_max(sc), mn = fmaxf(m, tm), al = expf(m - mn), p = expf(sc - mn);
    l = l * al + wave_sum(p); o0 *= al; o1 *= al; m = mn;
#pragma unroll 16
    for (int k = 0; k < 64; ++k) { const float pk = __shfl(p, k); const unsigned w = *(const unsigned*)(Vt + (size_t)k * 128 + 2 * lane);
        o0 += pk * bf2f(w & 0xffff); o1 += pk * bf2f(w >> 16); }
}
__device__ __forceinline__ void attn_naive_phase(Frame& F, const bf16* QKV, bf16* Y, const float* sinks, const float* relb, const float* lq1, const float* lk1, const float* lq2, const float* lk2, const float* subg, float lam_init) {
    int lane_ = F.lane; asm volatile("" : "+v"(lane_));
    const int gw = F.vcu * NWAVES + F.wave, NGW = F.G * NWAVES, lane = lane_;
    const float lam = expf(wave_sum(lq1[lane] * lk1[lane])) - expf(wave_sum(lq2[lane] * lk2[lane])) + lam_init;
    for (int it = gw; it < 4 * S; it += NGW) { const int s = it >> 2, h = it & 3, c = s >> 6;
        float q1[64], q2[64]; load_q<64>(q1, QKV + O_QB + (size_t)h * HS + (size_t)s * 128); load_q<64>(q2, QKV + O_QB + (size_t)h * HS + (size_t)s * 128 + 64);
        float m1 = -1e30f, l1 = 0.f, a0 = 0.f, a1 = 0.f, m2 = -1e30f, l2 = 0.f, b0 = 0.f, b1 = 0.f;
        const bf16* Kh = QKV + O_KB + (size_t)h * HS; const bf16* Vh = QKV + O_VB + (size_t)h * HS;
        for (int t = 0; t <= c; ++t) { const bf16* kr = Kh + (size_t)(64 * t + lane) * 128;
            const float s1 = dot_q<64>(q1, kr) * 0.125f, s2 = dot_q<64>(q2, kr + 64) * 0.125f;
            osm_tile(s1, m1, l1, a0, a1, Vh + (size_t)(64 * t) * 128, lane);
            osm_tile(s2, m2, l2, b0, b1, Vh + (size_t)(64 * t) * 128, lane); }
        const float d0 = a0 / l1 - lam * (b0 / l2), d1 = a1 / l1 - lam * (b1 / l2);
        const float r = 1.0f / sqrtf(wave_sum(d0 * d0 + d1 * d1) * (1.f / 128.f) + LN_EPS) * (1.0f - lam_init);
        *(unsigned*)(Y + (size_t)s * DM + 1024 + h * 128 + 2 * lane) = pk2(d0 * r * subg[2 * lane], d1 * r * subg[2 * lane + 1]); }
    for (int it = gw; it < 4 * S; it += NGW) { const int s = it >> 2, h = it & 3, c = s >> 6;
        float q[128]; load_q<128>(q, QKV + O_QC + (size_t)h * HS + (size_t)s * 128);
        float m = -1e30f, l = 0.f, o0 = 0.f, o1 = 0.f;
        const bf16* Kh = QKV + O_KC + (size_t)h * HS; const bf16* Vh = QKV + O_VC + (size_t)h * HS;
        for (int t = (c >= 8 ? c - 8 : 0); t <= c; ++t) { const int key = 64 * t + lane; int dist = s - key; dist = dist < -256 ? -256 : (dist > 256 ? 256 : dist);
            const float sc = dot_q<128>(q, Kh + (size_t)key * 128) * 0.08838834764831845f + relb[h * 513 + dist + 256];
            osm_tile(sc, m, l, o0, o1, Vh + (size_t)(64 * t) * 128, lane); }
        *(unsigned*)(Y + (size_t)s * DM + 1536 + h * 128 + 2 * lane) = pk2(o0 / l, o1 / l); }
    for (int it = gw; it < 8 * S; it += NGW) { const int s = it >> 3, hq = it & 7, kv = hq >> 2, c = s >> 6;
        float q[128]; load_q<128>(q, QKV + O_QA + (size_t)hq * HS + (size_t)s * 128);
        float m = sinks[hq], l = 1.0f, o0 = 0.f, o1 = 0.f;
        const bf16* Kh = QKV + O_KA + (size_t)kv * HS; const bf16* Vh = QKV + O_VA + (size_t)kv * HS;
        for (int t = (c >= 2 ? c - 2 : 0); t <= c; ++t) { const float sc = dot_q<128>(q, Kh + (size_t)(64 * t + lane) * 128) * 0.08838834764831845f;
            osm_tile(sc, m, l, o0, o1, Vh + (size_t)(64 * t) * 128, lane); }
        *(unsigned*)(Y + (size_t)s * DM + hq * 128 + 2 * lane) = pk2(o0 / l, o1 / l); }
}

__global__ void __launch_bounds__(NWAVES * 64, 2) mk_fwd(Args args) {
    extern __shared__ __attribute__((aligned(16))) unsigned char lds[];
    Frame F;
    F.lds = (LAS unsigned char*)lds; F.MISC = (volatile LAS unsigned*)(F.lds + MISC_OFF);
    F.tid = threadIdx.x; F.lane = F.tid & 63; F.wave = __builtin_amdgcn_readfirstlane(F.tid >> 6);
    F.G = gridDim.x; { const int bx = blockIdx.x; F.vcu = (F.G % 8 == 0) ? (bx % 8) * (F.G / 8) + bx / 8 : bx; }
    unsigned char* ws = args.ws; F.ctl = (gu32*)(ws + WS_CTL);
    for (int u = F.tid; u < (LDS_BYTES - LDSCTL_OFF) / 4; u += NWAVES * 64) ((LAS unsigned*)(F.lds + LDSCTL_OFF))[u] = 0u;
    __syncthreads();
    XcdBarrier bar = xcd_barrier_post((unsigned*)(F.ctl + CW_BAR), F.MISC + 8);
#define GRID_BAR() xcd_barrier_t<false>(bar)
#define PHASE_VARS GAS unsigned char* wsp = (GAS unsigned char*)ws; GAS float* outg = (GAS float*)args.out; int cbx = (int)blockIdx.x, Gx = F.G; asm volatile("" : "+s"(wsp), "+s"(outg), "+s"(cbx), "+s"(Gx)); float* outp = (float*)outg; \
    bf16* XB = (bf16*)(wsp + WS_XB); bf16* QKV = (bf16*)(wsp + WS_QKV); bf16* G = (bf16*)(wsp + WS_G); bf16* Y = (bf16*)(wsp + WS_Y); bf16* MIXB = (bf16*)(wsp + WS_MIXB); bf16* FB = (bf16*)(wsp + WS_F); \
    float* CSA = (float*)(wsp + WS_CSA); float* CSB = (float*)(wsp + WS_CSB); float* V32 = (float*)(wsp + WS_V32); float* MIX32 = (float*)(wsp + WS_MIX32); \
    const unsigned char* Wl = (const unsigned char*)(wsp + WS_W + (size_t)l * WL_SIZE); \
    (void)XB; (void)QKV; (void)G; (void)Y; (void)MIXB; (void)FB; (void)CSA; (void)CSB; (void)V32; (void)MIX32; (void)Wl; (void)outp; (void)cbx; (void)Gx

    p0_prologue(F, args);
    xcd_barrier_t<true>(bar);

    for (int l = 0; l < DEPTH; ++l) {
        { PHASE_VARS;
          { pg8::Gemm g{XB, (const bf16*)(Wl + WL_W1), DM, DM}; pg8::StaticOrder So; So.init(S, INW, Gx, cbx);
            EpiIn E{QKV, CSA, CSB}; pg8::gemm_phase<EpiIn, pg8::StaticOrder, true>(F.lds, g, So, E); }
          { pg8::Gemm g{XB, (const bf16*)(Wl + WL_W1 + (size_t)INW * DM * 2), DM, DM}; pg8::StaticOrder So; So.init(S, GW, Gx, cbx);
            EpiGate E{G, args.in[13] + (size_t)l * GW}; pg8::gemm_phase<EpiGate, pg8::StaticOrder, true>(F.lds, g, So, E); } }
        GRID_BAR();
        { PHASE_VARS; const float lam_init = 0.8f - 0.6f * expf(-0.3f * (float)l);
          attn_naive_phase(F, QKV, Y, args.in[2] + l * 8, args.in[8] + (size_t)l * 4 * 513, args.in[3] + l * 64, args.in[4] + l * 64, args.in[5] + l * 64, args.in[6] + l * 64, args.in[7] + l * 128, lam_init); }
        GRID_BAR();
        { PHASE_VARS; pg8::StaticOrder So; So.init(S, DM, Gx, cbx);
          { pg8::Gemm g{Y, (const bf16*)(Wl + WL_BA), DM, 1024}; EpiBr<0> E{G, 0, 0, MIX32, MIXB}; pg8::gemm_phase<EpiBr<0>, pg8::StaticOrder, false>(F.lds, g, So, E); }
          { pg8::Gemm g{Y + 1024, (const bf16*)(Wl + WL_BB), DM, 512}; EpiBr<1> E{G, 2048, 0, MIX32, MIXB}; pg8::gemm_phase<EpiBr<1>, pg8::StaticOrder, false>(F.lds, g, So, E); }
          { pg8::Gemm g{Y + 1536, (const bf16*)(Wl + WL_BC), DM, 512}; EpiBr<2> E{G, 4096, 0, MIX32, MIXB}; pg8::gemm_phase<EpiBr<2>, pg8::StaticOrder, false>(F.lds, g, So, E); } }
        GRID_BAR();
        { PHASE_VARS; const float* xres = (l == 0) ? args.in[0] : (const float*)outp;
          pg8::Gemm g{MIXB, (const bf16*)(Wl + WL_WO), DM, DM}; pg8::StaticOrder So; So.init(S, DM, Gx, cbx);
          EpiRes E{xres, V32}; pg8::gemm_phase<EpiRes, pg8::StaticOrder, false>(F.lds, g, So, E); }
        GRID_BAR();
        { PHASE_VARS; ln_phase(F, V32, args.in[15] + (size_t)l * DM, args.in[16] + (size_t)l * DM, outp, XB); }
        GRID_BAR();
        { PHASE_VARS; pg8::Gemm g{XB, (const bf16*)(Wl + WL_F1), DM, DM}; pg8::StaticOrder So; So.init(S, 2 * FH, Gx, cbx);
          EpiSwiGLU E{FB}; pg8::gemm_phase<EpiSwiGLU, pg8::StaticOrder, true>(F.lds, g, So, E); }
        GRID_BAR();
        { PHASE_VARS; pg8::Gemm g{FB, (const bf16*)(Wl + WL_F2), FH, FH}; pg8::StaticOrder So; So.init(S, DM, Gx, cbx);
          EpiRes E{outp, V32}; pg8::gemm_phase<EpiRes, pg8::StaticOrder, false>(F.lds, g, So, E); }
        GRID_BAR();
        { PHASE_VARS; ln_phase(F, V32, args.in[19] + (size_t)l * DM, args.in[20] + (size_t)l * DM, outp, XB); }
        GRID_BAR();
    }
}

extern "C" void kernel_launch(void* const* d_in, const int* in_sizes, int n_in, void* d_out, int out_size, void* d_ws, size_t ws_size, hipStream_t stream) {
    static int grid = 0;
    if (grid == 0) {
        if (n_in != 21 || out_size != S * DM || ws_size < WS_END) { fprintf(stderr, "kernel_launch: unexpected shapes (n_in %d out %d ws %zu need %zu)\n", n_in, out_size, ws_size, (size_t)WS_END); grid = -1; return; }
        int dev = 0, cus = 0, per_cu = 0;
        if (hipGetDevice(&dev) != hipSuccess || hipDeviceGetAttribute(&cus, hipDeviceAttributeMultiprocessorCount, dev) != hipSuccess) { grid = -1; return; }
        if (hipFuncSetAttribute((const void*)mk_fwd, hipFuncAttributeMaxDynamicSharedMemorySize, LDS_BYTES) != hipSuccess) { fprintf(stderr, "kernel_launch: hipFuncSetAttribute failed\n"); grid = -1; return; }
        if (hipOccupancyMaxActiveBlocksPerMultiprocessor(&per_cu, (const void*)mk_fwd, NWAVES * 64, LDS_BYTES) != hipSuccess || per_cu < 1) fprintf(stderr, "kernel_launch: occupancy query reports %d\n", per_cu);
        (void)hipGetLastError();
        grid = cus;
    }
    if (grid < 0) return;
    if (hipMemsetAsync((char*)d_ws + WS_CTL, 0, CTL_ZERO_BYTES, stream) != hipSuccess) return;
    Args a{};
    for (int i = 0; i < 21; ++i) a.in[i] = (const float*)d_in[i];
    a.out = (float*)d_out; a.ws = (unsigned char*)d_ws;
    hipLaunchKernelGGL(mk_fwd, dim3(grid), dim3(NWAVES * 64), LDS_BYTES, stream, a);
}
```

```cpp
#include <hip/hip_runtime.h>
#include <cstdio>
#include <cstdint>
#include <cmath>

namespace pg8 {
#define PG8_LAS __attribute__((address_space(3)))
typedef unsigned short bf16_t;
typedef short bf16x8 __attribute__((ext_vector_type(8)));
typedef float f32x4 __attribute__((ext_vector_type(4)));
typedef unsigned u32x4 __attribute__((ext_vector_type(4)));
typedef unsigned u32x2 __attribute__((ext_vector_type(2)));
constexpr int BM = 256, BK = 64, HALF = 128, HTB = HALF * BK * 2  , STAGE_BYTES = 8 * HTB, NXCD = 8, WGM = 8;

__host__ __device__ __forceinline__ int lds_byte(int r, int c) { const int st = (r >> 4) * 2 + (c >> 5), rr = r & 15, cc = c & 31, ob = rr * 64 + cc * 2; return st * 1024 + (ob ^ (((ob >> 9) & 1) << 5)); }
__host__ __device__ __forceinline__ void stage_rc(int b, int& R, int& C) { const int st = b / 1024, sb = b % 1024, swz = sb ^ (((sb >> 9) & 1) << 5); R = (st >> 1) * 16 + swz / 64; C = (st & 1) * 32 + (swz % 64) / 2; }

struct Unit { int pm, pn; };
struct Gemm { const bf16_t* A; const bf16_t* Bt; int lda, K; };

struct StaticOrder {
    int nM, nN, nwg, G, c;
    __host__ __device__ void init(int M, int N, int G_, int c_) { nM = M / BM; nN = N / BM; nwg = nM * nN; G = G_; c = c_; }
    __host__ __device__ bool next(int i, Unit& u) const {
        const long L = (long)i * G + c; if (L >= nwg) return false;
        int wgid = (int)L; { const int q = nwg / NXCD, r = nwg % NXCD, xcd = wgid % NXCD, off = wgid / NXCD; wgid = (xcd < r ? xcd * (q + 1) : r * (q + 1) + (xcd - r) * q) + off; }
        const int nig = WGM * nN, gid = wgid / nig, fm = gid * WGM, gsz = (nM - fm) < WGM ? (nM - fm) : WGM;
        u.pm = fm + ((wgid % nig) % gsz); u.pn = (wgid % nig) / gsz; return true;
    }
    __device__ __forceinline__ void a_ready(const Unit&) const {}
    __device__ __forceinline__ void done(const Unit&) const {}
};

template <class Epi, class Sched, bool ALIGN_EPI>
__device__ __forceinline__ void gemm_phase(PG8_LAS unsigned char* lds, const Gemm g, const Sched& S, const Epi& E) {
    int tid_ = threadIdx.x; asm volatile("" : "+v"(tid_));
    const int tid = tid_, wid = __builtin_amdgcn_readfirstlane(tid >> 6), lane = tid & 63, wr = wid >> 2, wc = wid & 3, fr = lane & 15, fq = lane >> 4;
    const int K = g.K, lda = g.lda, nt = K / BK;
    unsigned voffA[2], voffB[2];
#pragma unroll
    for (int i = 0; i < 2; ++i) { int R, C; stage_rc(tid * 16 + i * 8192, R, C);
        voffA[i] = (unsigned)(R * lda + C) * 2u; voffB[i] = (unsigned)(R * K + C) * 2u; }
    const size_t kstep = (size_t)(BK * 2);
    const size_t hstepA = (size_t)HALF * lda * 2, hstepB = (size_t)HALF * K * 2;
    const size_t tstepA = 2 * hstepA, tstepB = 2 * hstepB;
    const unsigned ldsw = (unsigned)wid * 1024u;
    const int aoff = lds_byte(wr * 64 + fr, fq * 8), boff = lds_byte(wc * 32 + fr, fq * 8);
#define PG8_SA(b, h) (((b) * 2 + (h)) * HTB)
#define PG8_SB(b, h) ((4 + (b) * 2 + (h)) * HTB)
#define PG8_STAGE(bufoff, gbase, voff) do { _Pragma("unroll") for (int _i = 0; _i < 2; ++_i) \
        __builtin_amdgcn_global_load_lds((const unsigned*)((const char*)(gbase) + (voff)[_i]), (PG8_LAS unsigned*)(lds + (bufoff) + ldsw + _i * 8192), 16, 0, 0); } while (0)
#define PG8_LDA(dst, b, h) do { _Pragma("unroll") for (int m = 0; m < 4; ++m) _Pragma("unroll") for (int k = 0; k < 2; ++k) dst[m][k] = *(const PG8_LAS bf16x8*)(lds + PG8_SA(b, h) + aoff + m * 2048 + k * 1024); } while (0)
#define PG8_LDB(dst, b, h) do { _Pragma("unroll") for (int n = 0; n < 2; ++n) _Pragma("unroll") for (int k = 0; k < 2; ++k) dst[n][k] = *(const PG8_LAS bf16x8*)(lds + PG8_SB(b, h) + boff + n * 2048 + k * 1024); } while (0)
#define PG8_MMA(ai, bj, At, Bt) do { __builtin_amdgcn_s_setprio(1); _Pragma("unroll") for (int m = 0; m < 4; ++m) _Pragma("unroll") for (int n = 0; n < 2; ++n) _Pragma("unroll") for (int k = 0; k < 2; ++k) \
        acc[ai][bj][m][n] = __builtin_amdgcn_mfma_f32_16x16x32_bf16(Bt[n][k], At[m][k], acc[ai][bj][m][n], 0, 0, 0); __builtin_amdgcn_s_setprio(0); } while (0)
#define PG8_WAIT_V(n) asm volatile("s_waitcnt vmcnt(" #n ")" ::: "memory")
#define PG8_WAIT_L(n) asm volatile("s_waitcnt lgkmcnt(" #n ")" ::: "memory")
#define PG8_BAR __builtin_amdgcn_s_barrier()
#define PG8_SCHED __builtin_amdgcn_sched_barrier(0)
    Unit cur, nxt; int ui = 0;
    if (!S.next(0, cur)) return;
    f32x4 acc[2][2][4][2];
#pragma unroll
    for (int a = 0; a < 2; ++a)
#pragma unroll
        for (int b = 0; b < 2; ++b)
#pragma unroll
            for (int m = 0; m < 4; ++m)
#pragma unroll
                for (int n = 0; n < 2; ++n) acc[a][b][m][n] = (f32x4){0.f, 0.f, 0.f, 0.f};
    bf16x8 At[4][2], B0[2][2], B1[2][2];
    const char* cA = (const char*)g.A + (size_t)cur.pm * tstepA; const char* cB = (const char*)g.Bt + (size_t)cur.pn * tstepB;
    S.a_ready(cur);
    PG8_STAGE(PG8_SB(0, 0), cB, voffB); PG8_STAGE(PG8_SB(0, 1), cB + hstepB, voffB); PG8_STAGE(PG8_SA(0, 0), cA, voffA); PG8_STAGE(PG8_SA(0, 1), cA + hstepA, voffA);
    if (wr == 1) PG8_BAR;
    PG8_WAIT_V(2); PG8_BAR;
    PG8_STAGE(PG8_SB(1, 0), cB + kstep, voffB); PG8_STAGE(PG8_SA(1, 0), cA + kstep, voffA); PG8_STAGE(PG8_SB(1, 1), cB + hstepB + kstep, voffB);
    PG8_WAIT_V(6); PG8_BAR;
    for (;;) {
        const bool has_next = S.next(ui + 1, nxt);
        const char* nA = has_next ? (const char*)g.A + (size_t)nxt.pm * tstepA : cA; const char* nB = has_next ? (const char*)g.Bt + (size_t)nxt.pn * tstepB : cB;
        for (int t = 0; t < nt; t += 2) {
            const bool last = (t == nt - 2);
            const char* a1 = cA + (size_t)(t + 1) * kstep;
            const char* a2 = last ? nA : cA + (size_t)(t + 2) * kstep; const char* b2 = last ? nB : cB + (size_t)(t + 2) * kstep;
            const char* a3 = a2 + kstep; const char* b3 = b2 + kstep;
            if (last && has_next) S.a_ready(nxt);
            PG8_LDB(B0, 0, 0); PG8_LDB(B1, 0, 1); PG8_SCHED; PG8_LDA(At, 0, 0); PG8_STAGE(PG8_SA(1, 1), a1 + hstepA, voffA);
            PG8_WAIT_V(8); PG8_WAIT_L(0); PG8_BAR; PG8_MMA(0, 0, At, B0); PG8_MMA(0, 1, At, B1); PG8_BAR; PG8_SCHED;
            PG8_LDA(At, 0, 1); PG8_STAGE(PG8_SB(0, 0), b2, voffB); PG8_STAGE(PG8_SB(0, 1), b2 + hstepB, voffB); PG8_STAGE(PG8_SA(0, 0), a2, voffA);
            PG8_WAIT_V(8); PG8_WAIT_L(0); PG8_BAR; PG8_MMA(1, 0, At, B0); PG8_MMA(1, 1, At, B1); PG8_BAR; PG8_SCHED;
            PG8_LDB(B0, 1, 0); PG8_LDB(B1, 1, 1); PG8_SCHED; PG8_LDA(At, 1, 0); PG8_STAGE(PG8_SA(0, 1), a2 + hstepA, voffA);
            PG8_WAIT_V(8); PG8_WAIT_L(0); PG8_BAR; PG8_MMA(0, 0, At, B0); PG8_MMA(0, 1, At, B1); PG8_BAR; PG8_SCHED;
            PG8_LDA(At, 1, 1); PG8_STAGE(PG8_SB(1, 0), b3, voffB); PG8_STAGE(PG8_SB(1, 1), b3 + hstepB, voffB); PG8_STAGE(PG8_SA(1, 0), a3, voffA);
            PG8_WAIT_V(8); PG8_WAIT_L(0); PG8_BAR; PG8_MMA(1, 0, At, B0); PG8_MMA(1, 1, At, B1); PG8_BAR; PG8_SCHED;
        }
        if constexpr (ALIGN_EPI) { if (wr == 0) PG8_BAR; }
        E(acc, cur, wr, wc, fr, fq); S.done(cur);
        if (!has_next) break;
#pragma unroll
        for (int a = 0; a < 2; ++a)
#pragma unroll
            for (int b = 0; b < 2; ++b)
#pragma unroll
                for (int m = 0; m < 4; ++m)
#pragma unroll
                    for (int n = 0; n < 2; ++n) acc[a][b][m][n] = (f32x4){0.f, 0.f, 0.f, 0.f};
        cur = nxt; cA = nA; cB = nB; ++ui;
        if constexpr (ALIGN_EPI) { if (wr == 1) PG8_BAR; }
    }
    PG8_WAIT_V(0);
    if constexpr (!ALIGN_EPI) { if (wr == 0) PG8_BAR; }
    PG8_BAR;
#undef PG8_SA
#undef PG8_SB
#undef PG8_STAGE
#undef PG8_LDA
#undef PG8_LDB
#undef PG8_MMA
#undef PG8_WAIT_V
#undef PG8_WAIT_L
#undef PG8_BAR
#undef PG8_SCHED
}
}

typedef unsigned short bf16;
typedef short bf16x8 __attribute__((ext_vector_type(8)));
typedef float f32x4 __attribute__((ext_vector_type(4)));
typedef float f32x2 __attribute__((ext_vector_type(2)));
typedef unsigned u32x4 __attribute__((ext_vector_type(4)));
typedef unsigned u32x2 __attribute__((ext_vector_type(2)));
#define GAS __attribute__((address_space(1)))
#define LAS __attribute__((address_space(3)))
typedef GAS unsigned gu32;

constexpr int S = 8192, DM = 2048, DEPTH = 4, INW = 4608, GW = 6144, FH = 5632;
constexpr float LN_EPS = 1e-5f;
constexpr float ALPHA = 1.6817928305074290f;
constexpr float LOG2E = 1.4426950408889634f;
constexpr float C2_A = 0.08838834764831845f * LOG2E, C2_B = 0.125f * LOG2E;
constexpr size_t MiB = 1u << 20;
constexpr int NWAVES = 8;

constexpr size_t WL_W1 = 0;
constexpr size_t WL_BA = WL_W1 + (size_t)10752 * 2048 * 2;
constexpr size_t WL_BB = WL_BA + (size_t)2048 * 1024 * 2;
constexpr size_t WL_BC = WL_BB + (size_t)2048 * 512 * 2;
constexpr size_t WL_WO = WL_BC + (size_t)2048 * 512 * 2;
constexpr size_t WL_F1 = WL_WO + (size_t)2048 * 2048 * 2;
constexpr size_t WL_F2 = WL_F1 + (size_t)11264 * 2048 * 2;
constexpr size_t WL_SIZE = WL_F2 + (size_t)2048 * 5632 * 2;
constexpr size_t WS_CTL = 0, CTL_ZERO_BYTES = 1 * MiB;
constexpr size_t WS_W = 1 * MiB;
constexpr size_t WS_XB = WS_W + 4 * WL_SIZE;
constexpr size_t WS_QKV = WS_XB + (size_t)S * DM * 2;
constexpr size_t WS_G = WS_QKV + (size_t)S * INW * 2;
constexpr size_t WS_Y = WS_G + (size_t)S * GW * 2;
constexpr size_t WS_MIXB = WS_Y + (size_t)S * DM * 2;
constexpr size_t WS_F = WS_MIXB + (size_t)S * DM * 2;
constexpr size_t WS_CSA = WS_F + (size_t)S * FH * 2;
constexpr size_t WS_CSB = WS_CSA + (size_t)S * 64 * 2 * 4;
constexpr size_t WS_V32 = WS_CSB + (size_t)S * 32 * 2 * 4;
constexpr size_t WS_MIX32 = WS_V32 + (size_t)S * DM * 4;
constexpr size_t WS_PB = WS_MIX32 + (size_t)S * DM * 4;
constexpr size_t WS_PML = WS_PB + (size_t)16 * S * 128 * 4;
constexpr size_t WS_END = WS_PML + (size_t)16 * S * 2 * 4;
constexpr size_t HS = (size_t)S * 128;
constexpr size_t O_QA = 0, O_KA = 8 * HS, O_VA = 10 * HS, O_QB = 12 * HS, O_KB = 16 * HS, O_VB = 20 * HS, O_QC = 24 * HS, O_KC = 28 * HS, O_VC = 32 * HS;
constexpr int CW_BAR = 4096;
constexpr int RING_BYTES = 131072, LDSCTL_OFF = RING_BYTES, MISC_OFF = LDSCTL_OFF + 320, LDS_BYTES = 147456;

__device__ __forceinline__ unsigned f2bf(float f) { unsigned u = __builtin_bit_cast(unsigned, f); return (u + 0x7fffu + ((u >> 16) & 1u)) >> 16; }
__device__ __forceinline__ unsigned pk2(float lo, float hi) { return f2bf(lo) | (f2bf(hi) << 16); }
__device__ __forceinline__ float bf2f(unsigned short b) { return __builtin_bit_cast(float, (unsigned)b << 16); }
__device__ __forceinline__ u32x2 pk4(f32x4 v) { u32x2 o; o.x = pk2(v[0], v[1]); o.y = pk2(v[2], v[3]); return o; }
__device__ __forceinline__ f32x4 unpk4(u32x2 w) { f32x4 g; g[0] = bf2f(w.x & 0xffff); g[1] = bf2f(w.x >> 16); g[2] = bf2f(w.y & 0xffff); g[3] = bf2f(w.y >> 16); return g; }
__device__ __forceinline__ float wave_sum(float v) {
#pragma unroll
    for (int o = 1; o < 64; o <<= 1) v += __shfl_xor(v, o);
    return v;
}
__device__ __forceinline__ float wave_max(float v) {
#pragma unroll
    for (int o = 1; o < 64; o <<= 1) v = fmaxf(v, __shfl_xor(v, o));
    return v;
}
__device__ __forceinline__ float fsigmoid(float z) { return __builtin_amdgcn_rcpf(1.0f + __builtin_amdgcn_exp2f(-z * LOG2E)); }

#define XB_TMO      128
#define XB_XCNT(j)  (256  + 64 * (j))
#define XB_XSUB(j)  (1280 + 64 * (j))
#define XB_XGEN(j)  (2304 + 64 * (j))
#define XB_TOP      3328
#define XB_TOPGEN   3392
#define XCD_BAR_WORDS 3456
#define XB_SPIN_CAP (1u << 18)
__device__ __forceinline__ unsigned xb_ld(unsigned* p)              { return __hip_atomic_load(p, __ATOMIC_RELAXED, __HIP_MEMORY_SCOPE_AGENT); }
__device__ __forceinline__ unsigned xb_add(unsigned* p, unsigned v) { return __hip_atomic_fetch_add(p, v, __ATOMIC_RELAXED, __HIP_MEMORY_SCOPE_AGENT); }
__device__ __forceinline__ unsigned xb_xcc_id() { return (unsigned)__builtin_amdgcn_s_getreg((3 << 11) | 20) & 0xFu; }
#define XB_SPIN(cond, bar) do { unsigned _sp = 0; while (cond) { __builtin_amdgcn_s_sleep(1); \
    if ((++_sp & 255u) == 0u) { if (xb_ld(&(bar)[XB_TMO])) break; if (_sp > XB_SPIN_CAP) { atomicAdd(&(bar)[XB_TMO], 1u); break; } } } } while (0)
struct XcdBarrier { unsigned* bar; unsigned x; volatile LAS unsigned* st; };
__device__ __forceinline__ XcdBarrier xcd_barrier_post(unsigned* bar, volatile LAS unsigned* st) {
    XcdBarrier b; b.bar = bar; b.x = xb_xcc_id(); b.st = st;
    if (threadIdx.x == 0) (void)xb_add(&bar[XB_XCNT(b.x)], 1u);
    return b;
}
__device__ __forceinline__ void xcd_barrier_complete(unsigned* bar, unsigned x, unsigned& nloc, unsigned& nx) {
    const unsigned G = gridDim.x * gridDim.y * gridDim.z;
    unsigned sum, cnt, mine, sp = 0u;
    for (;;) {
        sum = 0u; cnt = 0u; mine = 0u;
#pragma unroll
        for (unsigned j = 0; j < 16; ++j) { const unsigned c = xb_ld(&bar[XB_XCNT(j)]); sum += c; cnt += (c > 0u) ? 1u : 0u; mine = (j == x) ? c : mine; }
        if (sum == G) break;
        __builtin_amdgcn_s_sleep(1);
        if ((++sp & 255u) == 0u) { if (xb_ld(&bar[XB_TMO])) break; if (sp > XB_SPIN_CAP) { atomicAdd(&bar[XB_TMO], 1u); break; } }
    }
    nloc = mine > 0u ? mine : 1u; nx = cnt > 0u ? cnt : 1u;
}
template <bool FIRST>
__device__ __forceinline__ void xcd_barrier_t(const XcdBarrier& b) {
    asm volatile("s_waitcnt vmcnt(0)" ::: "memory");
    __syncthreads();
    if (threadIdx.x == 0) {
        GAS unsigned* barg = (GAS unsigned*)b.bar; unsigned x = b.x;
        asm volatile("" : "+s"(barg), "+s"(x)); unsigned* bar = (unsigned*)barg;
        __builtin_amdgcn_s_waitcnt(0);
        unsigned nloc = b.st[0], nx = b.st[1];
        if (FIRST) { if (nloc == 0u) { xcd_barrier_complete(bar, x, nloc, nx); b.st[0] = nloc; b.st[1] = nx; } }
        else { nloc = nloc ? nloc : 1u; nx = nx ? nx : 1u; }
        const unsigned old = xb_add(&bar[XB_XSUB(x)], 1u);
        const unsigned gen = old / nloc;
        if (old + 1u == (gen + 1u) * nloc) {
            __builtin_amdgcn_fence(__ATOMIC_RELEASE, "agent");
            asm volatile("s_waitcnt vmcnt(0)" ::: "memory");
            const unsigned og = xb_add(&bar[XB_TOP], 1u);
            const unsigned tg = og / nx;
            if (og + 1u == (tg + 1u) * nx) xb_add(&bar[XB_TOPGEN], 1u);
            else XB_SPIN(xb_ld(&bar[XB_TOPGEN]) == tg, bar);
            __builtin_amdgcn_fence(__ATOMIC_ACQUIRE, "agent");
            xb_add(&bar[XB_XGEN(x)], 1u);
            asm volatile("s_waitcnt vmcnt(0)" ::: "memory");
        } else {
            XB_SPIN(xb_ld(&bar[XB_XGEN(x)]) == gen, bar);
            __builtin_amdgcn_fence(__ATOMIC_ACQUIRE, "agent");
            asm volatile("s_waitcnt vmcnt(0)" ::: "memory");
        }
    }
    __syncthreads();
}

using pg8::Unit;
struct EpiIn { bf16* QKV; const float* csa; const float* csb;
    static constexpr bool PERM = false;
    __device__ __forceinline__ void operator()(const f32x4 (&acc)[2][2][4][2], const Unit& u, int wr, int wc, int fr_, int fq_) const {
        int fr = fr_, fq = fq_; asm volatile("" : "+v"(fr), "+v"(fq));
#pragma unroll
        for (int bj = 0; bj < 2; ++bj) { const int hh = u.pn * 2 + bj; bf16* hb = QKV + (size_t)hh * HS;
            if (hh < 10) {
                const int d0 = 16 * wc + 4 * fq; const float qs = hh < 8 ? C2_A : 1.0f;
#pragma unroll
                for (int ai = 0; ai < 2; ++ai)
#pragma unroll
                    for (int m = 0; m < 4; ++m) { const int s = u.pm * 256 + ai * 128 + wr * 64 + m * 16 + fr; const f32x4 x0 = acc[ai][bj][m][0] * qs, x1 = acc[ai][bj][m][1] * qs;
                        const f32x4 cs0 = *(const f32x4*)(csa + ((size_t)s * 64 + d0) * 2), cs1 = *(const f32x4*)(csa + ((size_t)s * 64 + d0) * 2 + 4);
                        const f32x4 c = {cs0[0], cs0[2], cs1[0], cs1[2]}, sn = {cs0[1], cs0[3], cs1[1], cs1[3]};
                        const f32x4 o0 = x0 * c - x1 * sn, o1 = x1 * c + x0 * sn;
                        *(u32x2*)(hb + (size_t)s * 128 + d0) = pk4(o0); *(u32x2*)(hb + (size_t)s * 128 + d0 + 64) = pk4(o1); }
            } else if (hh >= 12 && hh < 20) {
                const int dd = 16 * (wc & 1) + 4 * fq, cb = 64 * (wc >> 1); const float qs = hh < 16 ? C2_B : 1.0f;
#pragma unroll
                for (int ai = 0; ai < 2; ++ai)
#pragma unroll
                    for (int m = 0; m < 4; ++m) { const int s = u.pm * 256 + ai * 128 + wr * 64 + m * 16 + fr; const f32x4 x0 = acc[ai][bj][m][0] * qs, x1 = acc[ai][bj][m][1] * qs;
                        const f32x4 cs0 = *(const f32x4*)(csb + ((size_t)s * 32 + dd) * 2), cs1 = *(const f32x4*)(csb + ((size_t)s * 32 + dd) * 2 + 4);
                        const f32x4 c = {cs0[0], cs0[2], cs1[0], cs1[2]}, sn = {cs0[1], cs0[3], cs1[1], cs1[3]};
                        const f32x4 o0 = x0 * c - x1 * sn, o1 = x1 * c + x0 * sn;
                        *(u32x2*)(hb + (size_t)s * 128 + cb + dd) = pk4(o0); *(u32x2*)(hb + (size_t)s * 128 + cb + dd + 32) = pk4(o1); }
            } else {
                const int d0 = 32 * wc + 4 * fq; const float qs = (hh >= 24 && hh < 28) ? C2_A : 1.0f;
#pragma unroll
                for (int ai = 0; ai < 2; ++ai)
#pragma unroll
                    for (int m = 0; m < 4; ++m) { const int s = u.pm * 256 + ai * 128 + wr * 64 + m * 16 + fr;
                        *(u32x2*)(hb + (size_t)s * 128 + d0) = pk4(acc[ai][bj][m][0] * qs); *(u32x2*)(hb + (size_t)s * 128 + d0 + 16) = pk4(acc[ai][bj][m][1] * qs); }
            }
        }
    }
};
struct EpiGate { bf16* G; const float* bias;
    static constexpr bool PERM = false;
    __device__ __forceinline__ void operator()(const f32x4 (&acc)[2][2][4][2], const Unit& u, int wr, int wc, int fr, int fq) const {
#pragma unroll
        for (int bj = 0; bj < 2; ++bj)
#pragma unroll
            for (int n = 0; n < 2; ++n) { const int col = u.pn * 256 + bj * 128 + wc * 32 + n * 16 + 4 * fq; const f32x4 b = *(const f32x4*)(bias + col);
#pragma unroll
                for (int ai = 0; ai < 2; ++ai)
#pragma unroll
                    for (int m = 0; m < 4; ++m) { const int s = u.pm * 256 + ai * 128 + wr * 64 + m * 16 + fr; f32x4 v = acc[ai][bj][m][n] + b;
#pragma unroll
                        for (int r = 0; r < 4; ++r) v[r] = fsigmoid(v[r]);
                        *(u32x2*)(G + (size_t)s * GW + col) = pk4(v); } }
    }
};
template <int MODE> struct EpiBr { const bf16* G; int goff, pad; float* MIX32; bf16* MIXB;
    static constexpr bool PERM = false;
    __device__ __forceinline__ void operator()(const f32x4 (&acc)[2][2][4][2], const Unit& u, int wr, int wc, int fr, int fq) const {
#pragma unroll
        for (int ai = 0; ai < 2; ++ai)
#pragma unroll
            for (int m = 0; m < 4; ++m) { const int s = u.pm * 256 + ai * 128 + wr * 64 + m * 16 + fr;
#pragma unroll
                for (int bj = 0; bj < 2; ++bj)
#pragma unroll
                    for (int n = 0; n < 2; ++n) { const int col = u.pn * 256 + bj * 128 + wc * 32 + n * 16 + 4 * fq;
                        const f32x4 g = unpk4(*(const u32x2*)(G + (size_t)s * GW + goff + col)); f32x4 v = acc[ai][bj][m][n] * g; float* mp = MIX32 + (size_t)s * DM + col;
                        if (MODE >= 1) v += *(const f32x4*)mp;
                        if (MODE <= 1) *(f32x4*)mp = v; else *(u32x2*)(MIXB + (size_t)s * DM + col) = pk4(v); } }
    }
};
struct EpiRes { const float* xres; float* V32;
    static constexpr bool PERM = false;
    __device__ __forceinline__ void operator()(const f32x4 (&acc)[2][2][4][2], const Unit& u, int wr, int wc, int fr, int fq) const {
#pragma unroll
        for (int ai = 0; ai < 2; ++ai)
#pragma unroll
            for (int m = 0; m < 4; ++m) { const int s = u.pm * 256 + ai * 128 + wr * 64 + m * 16 + fr;
#pragma unroll
                for (int bj = 0; bj < 2; ++bj)
#pragma unroll
                    for (int n = 0; n < 2; ++n) { const size_t off = (size_t)s * DM + u.pn * 256 + bj * 128 + wc * 32 + n * 16 + 4 * fq;
                        *(f32x4*)(V32 + off) = *(const f32x4*)(xres + off) * ALPHA + acc[ai][bj][m][n]; } }
    }
};
struct EpiSwiGLU { bf16* F;
    static constexpr bool PERM = false;
    __device__ __forceinline__ void operator()(const f32x4 (&acc)[2][2][4][2], const Unit& u, int wr, int wc, int fr, int fq) const {
#pragma unroll
        for (int ai = 0; ai < 2; ++ai)
#pragma unroll
            for (int m = 0; m < 4; ++m) { const int s = u.pm * 256 + ai * 128 + wr * 64 + m * 16 + fr;
#pragma unroll
                for (int bj = 0; bj < 2; ++bj) { const f32x4 g = acc[ai][bj][m][0], up = acc[ai][bj][m][1]; f32x4 v;
#pragma unroll
                    for (int r = 0; r < 4; ++r) v[r] = g[r] * fsigmoid(g[r]) * up[r];
                    *(u32x2*)(F + (size_t)s * FH + u.pn * 128 + bj * 64 + wc * 16 + 4 * fq) = pk4(v); } }
    }
};

struct Args { const float* in[21]; float* out; unsigned char* ws; };
struct Frame {
    LAS unsigned char* lds; volatile LAS unsigned* MISC; gu32* ctl;
    int tid, lane, wave, vcu, G;
};

__device__ __forceinline__ int colmap(int kind, int nb) {
    if (kind == 1) return ((nb & 1) ? FH : 0) + (nb >> 1) * 16;
    if (kind == 2) { const int hh = nb >> 3, blk = nb & 7, wc = blk >> 1, n = blk & 1;
        if (hh < 10) return hh * 128 + 16 * wc + 64 * n;
        if (hh >= 12 && hh < 20) return hh * 128 + 64 * (wc >> 1) + 16 * (wc & 1) + 32 * n;
        return nb * 16; }
    return nb * 16;
}
__device__ __forceinline__ void p0_transpose_item(const float* W, int K, int Nsrc, int kind, bf16* WT, LAS float* scr, int item, int nblk, int lane) {
    const int kb = item / nblk, nb = item % nblk, k0 = 64 * kb, n0 = 32 * nb;
    const int scol = colmap(kind, 2 * nb + ((lane >> 4) & 1)) + (lane & 15);
#pragma unroll 8
    for (int i = 0; i < 32; ++i) { const int kk = 2 * i + (lane >> 5); scr[kk * 33 + (lane & 31)] = W[(size_t)(k0 + kk) * Nsrc + scol]; }
    asm volatile("s_waitcnt lgkmcnt(0)" ::: "memory");
    const int c = lane & 7;
#pragma unroll
    for (int j = 0; j < 4; ++j) { const int n = (lane >> 3) + 8 * j; const LAS float* s = scr + (8 * c) * 33 + n;
        u32x4 o; o.x = pk2(s[0 * 33], s[1 * 33]); o.y = pk2(s[2 * 33], s[3 * 33]); o.z = pk2(s[4 * 33], s[5 * 33]); o.w = pk2(s[6 * 33], s[7 * 33]);
        *(GAS u32x4*)(WT + (size_t)(n0 + n) * K + k0 + 8 * c) = o; }
    asm volatile("s_waitcnt lgkmcnt(0)" ::: "memory");
}
struct WDesc { int src, K, Nsrc, Ndst, kind; size_t dst; };
__device__ __forceinline__ void p0_prologue(Frame& F, const Args& a) {
    LAS float* scr = (LAS float*)(F.lds + F.wave * 16384);
    const int gw = F.vcu * NWAVES + F.wave, NGW = F.G * NWAVES;
    unsigned char* ws = a.ws;
#define WCVT(SRC, K_, NSRC, NDST, KIND, DSTOFF) do { const int nblk = (NDST) / 32, nit = ((K_) / 64) * nblk; \
        for (int l = 0; l < DEPTH; ++l) { const float* Wl = a.in[SRC] + (size_t)l * (K_) * (NSRC); bf16* WTl = (bf16*)(ws + WS_W + (size_t)l * WL_SIZE + (DSTOFF)); \
            for (int it = gw; it < nit; it += NGW) p0_transpose_item(Wl, (K_), (NSRC), (KIND), WTl, scr, it, nblk, F.lane); } } while (0)
    WCVT(1, DM, INW, INW, 2, WL_W1);
    WCVT(12, DM, GW, GW, 0, WL_W1 + (size_t)INW * DM * 2);
    WCVT(9, 1024, DM, DM, 0, WL_BA);
    WCVT(10, 512, DM, DM, 0, WL_BB);
    WCVT(11, 512, DM, DM, 0, WL_BC);
    WCVT(14, DM, DM, DM, 0, WL_WO);
    WCVT(17, DM, 2 * FH, 2 * FH, 1, WL_F1);
    WCVT(18, FH, DM, DM, 0, WL_F2);
#undef WCVT
    { const float* x = a.in[0]; bf16* xb = (bf16*)(ws + WS_XB);
        for (size_t i = ((size_t)blockIdx.x * 512 + F.tid) * 4; i < (size_t)S * DM; i += (size_t)F.G * 512 * 4) *(u32x2*)(xb + i) = pk4(*(const f32x4*)(x + i)); }
    { float* csa = (float*)(ws + WS_CSA); float* csb = (float*)(ws + WS_CSB);
        for (int idx = blockIdx.x * 512 + F.tid; idx < S * 96; idx += F.G * 512) { const int s = idx / 96, j = idx % 96;
            if (j < 64) { const float e = (float)(2 * j) / 128.0f; const float inv = 1.0f / powf(10000.0f, e); const float ang = (float)s * inv;
                csa[((size_t)s * 64 + j) * 2] = (float)cos((double)ang); csa[((size_t)s * 64 + j) * 2 + 1] = (float)sin((double)ang); }
            else { const int i = j - 64; const float e = (float)(2 * i) / 64.0f; const float inv = 1.0f / powf(10000.0f, e); const float ang = (float)s * inv;
                csb[((size_t)s * 32 + i) * 2] = (float)cos((double)ang); csb[((size_t)s * 32 + i) * 2 + 1] = (float)sin((double)ang); } } }
}

__device__ __forceinline__ void ln_phase(Frame& F, const float* V, const float* g, const float* b, float* xo, bf16* xb) {
    int lane_ = F.lane; asm volatile("" : "+v"(lane_));
    const int gw = F.vcu * NWAVES + F.wave, NGW = F.G * NWAVES, lane = lane_;
    for (int row = gw; row < S; row += NGW) {
        const f32x4* vr = (const f32x4*)(V + (size_t)row * DM) + lane;
        f32x4 v[8]; float s = 0.f;
#pragma unroll
        for (int j = 0; j < 8; ++j) { v[j] = vr[64 * j]; s += (v[j][0] + v[j][1]) + (v[j][2] + v[j][3]); }
        const float mean = wave_sum(s) * (1.f / DM); float q = 0.f;
#pragma unroll
        for (int j = 0; j < 8; ++j) { v[j] = v[j] - mean; q += (v[j][0] * v[j][0] + v[j][1] * v[j][1]) + (v[j][2] * v[j][2] + v[j][3] * v[j][3]); }
        const float rstd = 1.0f / sqrtf(wave_sum(q) * (1.f / DM) + LN_EPS);
#pragma unroll
        for (int j = 0; j < 8; ++j) { const int col = 4 * lane + 256 * j; const f32x4 gg = *(const f32x4*)(g + col), bb = *(const f32x4*)(b + col);
            const f32x4 y = v[j] * rstd * gg + bb; *(f32x4*)(xo + (size_t)row * DM + col) = y; *(u32x2*)(xb + (size_t)row * DM + col) = pk4(y); }
    }
}


namespace att {
typedef short s16x4 __attribute__((ext_vector_type(4)));
typedef float f32x16 __attribute__((ext_vector_type(16)));
constexpr int SHM_V = 16384, SHM_K = 16384;
constexpr int L_V = 0, L_K = 2 * SHM_V, L_WS = L_K + 2 * SHM_K, L_BIAS = L_WS + NWAVES * 64 * 4, L_END = L_BIAS + 2304;
constexpr float THR2 = 5.0f;
#define KSWZ(row, colB) ((row) * 256 + ((colB) ^ (((row) & 7) << 4)))
#define SBAR() __builtin_amdgcn_sched_barrier(0)
__device__ __forceinline__ int v_st(int k, int c) { const int kk = (k & ~0xC) | ((k & 4) << 1) | ((k & 8) >> 1); return ((kk >> 3) * 4 + (c >> 5)) * 512 + ((kk & 7) * 32 + (c & 31)) * 2; }
__device__ __forceinline__ int v_rd_base(int lane) { return ((lane & 3) << 3) | (((lane >> 2) & 3) << 6) | (((lane >> 4) & 1) << 5) | (((lane >> 5) & 1) << 8); }
constexpr int v_rd_off(int d0, int ks, int half) { return d0 * 512 + ks * 4096 + half * 2048; }
__device__ __forceinline__ int crow(int r, int hi) { return (r & 3) + 8 * (r >> 2) + 4 * hi; }
__device__ __forceinline__ unsigned cvtpk(float lo, float hi) { unsigned r; asm volatile("v_cvt_pk_bf16_f32 %0, %1, %2" : "=v"(r) : "v"(lo), "v"(hi)); return r; }

__device__ __forceinline__ void softmax_tile(f32x16& p0, f32x16& p1, float& m_reg, float& l_reg, float& alpha, bf16x8& pa0, bf16x8& pa1, bf16x8& pa2, bf16x8& pa3) {
    float pmax = p0[0];
#pragma unroll
    for (int r = 1; r < 16; ++r) pmax = fmaxf(pmax, p0[r]);
#pragma unroll
    for (int r = 0; r < 16; ++r) pmax = fmaxf(pmax, p1[r]);
    { auto rr = __builtin_amdgcn_permlane32_swap(__float_as_uint(pmax), __float_as_uint(pmax), false, false);
      pmax = fmaxf(__uint_as_float(rr[0]), __uint_as_float(rr[1])); }
    float mn;
    if (__all(pmax - m_reg <= THR2)) { mn = m_reg; alpha = 1.f; }
    else { mn = fmaxf(m_reg, pmax); alpha = __builtin_amdgcn_exp2f(m_reg - mn); m_reg = mn; }
#pragma unroll
    for (int r = 0; r < 16; ++r) p0[r] = __builtin_amdgcn_exp2f(p0[r] - mn);
#pragma unroll
    for (int r = 0; r < 16; ++r) p1[r] = __builtin_amdgcn_exp2f(p1[r] - mn);
    float ps = 0.f;
#pragma unroll
    for (int r = 0; r < 16; ++r) ps += p0[r];
#pragma unroll
    for (int r = 0; r < 16; ++r) ps += p1[r];
    { auto rr = __builtin_amdgcn_permlane32_swap(__float_as_uint(ps), __float_as_uint(ps), false, false);
      ps = __uint_as_float(rr[0]) + __uint_as_float(rr[1]); }
    l_reg = l_reg * alpha + ps;
#define PK4(P, B_, OUT) do { unsigned a0 = cvtpk(P[B_+0], P[B_+1]), a1 = cvtpk(P[B_+2], P[B_+3]);                          \
        unsigned b0 = cvtpk(P[B_+4], P[B_+5]), b1 = cvtpk(P[B_+6], P[B_+7]);                                             \
        auto r0 = __builtin_amdgcn_permlane32_swap(a0, b0, false, false); auto r1 = __builtin_amdgcn_permlane32_swap(a1, b1, false, false); \
        u32x4 w = {r0[0], r1[0], r0[1], r1[1]}; OUT = *reinterpret_cast<bf16x8*>(&w); } while (0)
    PK4(p0, 0, pa0); PK4(p0, 8, pa1); PK4(p1, 0, pa2); PK4(p1, 8, pa3);
#undef PK4
}
template <int KB, int ND>
__device__ __forceinline__ void qkt(f32x16& p0, f32x16& p1, const char* K_lds, int r32, int hi, const bf16x8* qr) {
    p0 = f32x16{}; p1 = f32x16{};
    const char* kb[4];
#pragma unroll
    for (int dd = 0; dd < 4; ++dd) kb[dd] = K_lds + KB * SHM_K + KSWZ(r32, (dd * 16 + hi * 8) * 2);
#pragma unroll
    for (int d0 = 0; d0 < ND; ++d0) { const char* a = kb[d0 & 3] + (d0 >> 2) * 128;
        bf16x8 b0 = *reinterpret_cast<const bf16x8*>(a);
        bf16x8 b1 = *reinterpret_cast<const bf16x8*>(a + 32 * 256);
        p0 = __builtin_amdgcn_mfma_f32_32x32x16_bf16(b0, qr[d0], p0, 0, 0, 0);
        p1 = __builtin_amdgcn_mfma_f32_32x32x16_bf16(b1, qr[d0], p1, 0, 0, 0); }
}
template <int VB>
__device__ __forceinline__ void pv_tile(f32x16* o, int vb0, bf16x8 pa0, bf16x8 pa1, bf16x8 pa2, bf16x8 pa3) {
#define TRRD(dst, off) asm volatile("ds_read_b64_tr_b16 %0, %1 offset:%2" : "=&v"(dst) : "v"(vb0), "i"(off) : "memory")
#define PV_D0(d0) do { s16x4 l0, l1, l2, l3, h0, h1, h2, h3; constexpr int b_ = VB * SHM_V + v_rd_off(d0, 0, 0); \
        TRRD(l0, b_); TRRD(h0, b_ + 2048); TRRD(l1, b_ + 4096); TRRD(h1, b_ + 6144); TRRD(l2, b_ + 8192); TRRD(h2, b_ + 10240); TRRD(l3, b_ + 12288); TRRD(h3, b_ + 14336); \
        asm volatile("s_waitcnt lgkmcnt(0)" ::: "memory"); SBAR();   \
        o[d0] = __builtin_amdgcn_mfma_f32_32x32x16_bf16(pa0, (bf16x8){l0[0], l0[1], l0[2], l0[3], h0[0], h0[1], h0[2], h0[3]}, o[d0], 0, 0, 0);   \
        o[d0] = __builtin_amdgcn_mfma_f32_32x32x16_bf16(pa1, (bf16x8){l1[0], l1[1], l1[2], l1[3], h1[0], h1[1], h1[2], h1[3]}, o[d0], 0, 0, 0);   \
        o[d0] = __builtin_amdgcn_mfma_f32_32x32x16_bf16(pa2, (bf16x8){l2[0], l2[1], l2[2], l2[3], h2[0], h2[1], h2[2], h2[3]}, o[d0], 0, 0, 0);   \
        o[d0] = __builtin_amdgcn_mfma_f32_32x32x16_bf16(pa3, (bf16x8){l3[0], l3[1], l3[2], l3[3], h3[0], h3[1], h3[2], h3[3]}, o[d0], 0, 0, 0); } while (0)
    PV_D0(0); PV_D0(1); PV_D0(2); PV_D0(3);
#undef PV_D0
#undef TRRD
}

struct UnitArgs {
    const bf16* Q;
    const bf16* K; const bf16* V;
    int t_lo, t_hi;
    int a_lo, a_hi;
    int koff;
    int qpos0;
    float m0, l0;
};
template <int MODE>
__device__ __forceinline__ void attn_unit(char* lds, const UnitArgs& U, f32x16 (&o)[4], float& m_reg, float& l_reg) {
    constexpr int ND = (MODE == 1) ? 4 : 8;
    int tid_ = threadIdx.x; asm volatile("" : "+v"(tid_));
    const int tid = tid_, lane = tid & 63, r32 = lane & 31, hi = lane >> 5; const int wid = __builtin_amdgcn_readfirstlane(tid >> 6);
    char* V_lds = lds + L_V; char* K_lds = lds + L_K;
    float* ws = (float*)(lds + L_WS) + wid * 64; float* al_l = ws + 32;
    const float* btab = (const float*)(lds + L_BIAS);
    const int sr = tid >> 4, sc = (tid & 15) * 8, vst0 = v_st(sr, sc), vst1 = v_st(32 + sr, sc), kws = KSWZ(sr, sc * 2);
    const int vb0 = (int)(uintptr_t)V_lds + v_rd_base(lane);
    const char* Kw = K_lds + U.koff;
    m_reg = U.m0; l_reg = U.l0;
#pragma unroll
    for (int d = 0; d < 4; ++d) o[d] = f32x16{};
    bf16x8 st_k0, st_k1, st_v0, st_v1;
#define SLOAD(t) do { const size_t ro_ = (size_t)(64 * (t) + sr) * 128 + sc; st_k0 = *(const bf16x8*)(U.K + ro_); st_k1 = *(const bf16x8*)(U.K + ro_ + 32 * 128); \
                      st_v0 = *(const bf16x8*)(U.V + ro_); st_v1 = *(const bf16x8*)(U.V + ro_ + 32 * 128); } while (0)
#define SWRITE(bf) do { *(bf16x8*)(K_lds + (bf) * SHM_K + kws) = st_k0; *(bf16x8*)(K_lds + (bf) * SHM_K + kws + 32 * 256) = st_k1; \
                        *(bf16x8*)(V_lds + (bf) * SHM_V + vst0) = st_v0; *(bf16x8*)(V_lds + (bf) * SHM_V + vst1) = st_v1; } while (0)
    bf16x8 qr[ND];
#pragma unroll
    for (int d0 = 0; d0 < ND; ++d0) qr[d0] = *(const bf16x8*)(U.Q + (size_t)r32 * 128 + d0 * 16 + hi * 8);
    SBAR();
    SLOAD(U.t_lo);
    SWRITE(0);
    __syncthreads();
#define STEP(t, B) do { \
        if ((t) + 1 < U.t_hi) SLOAD((t) + 1); SBAR(); \
        if ((t) >= U.a_lo && (t) <= U.a_hi) { \
            f32x16 p0, p1; float alpha; bf16x8 pa0, pa1, pa2, pa3; \
            qkt<B, ND>(p0, p1, Kw, r32, hi, qr); \
            if (MODE == 2) { const int dq = U.qpos0 + r32 - 64 * (t) - 4 * hi; \
                _Pragma("unroll") for (int r = 0; r < 16; ++r) { const int c_ = (r & 3) + 8 * (r >> 2); int d0_ = dq - c_, d1_ = dq - c_ - 32; \
                    d0_ = d0_ < -256 ? -256 : (d0_ > 256 ? 256 : d0_); d1_ = d1_ < -256 ? -256 : (d1_ > 256 ? 256 : d1_); p0[r] += btab[d0_ + 256]; p1[r] += btab[d1_ + 256]; } } \
            softmax_tile(p0, p1, m_reg, l_reg, alpha, pa0, pa1, pa2, pa3); \
            if (__any(alpha < 1.f)) { if (hi == 0) al_l[r32] = alpha; asm volatile("s_waitcnt lgkmcnt(0)" ::: "memory"); \
                _Pragma("unroll") for (int d_ = 0; d_ < 4; ++d_) _Pragma("unroll") for (int r = 0; r < 16; ++r) o[d_][r] *= al_l[crow(r, hi)]; } \
            SBAR(); pv_tile<B>(o, vb0, pa0, pa1, pa2, pa3); } \
        SBAR(); if ((t) + 1 < U.t_hi) SWRITE((B) ^ 1); \
        __syncthreads(); } while (0)
    for (int t = U.t_lo; t < U.t_hi; t += 2) { STEP(t, 0); if (t + 1 < U.t_hi) STEP(t + 1, 1); }
#undef STEP
#undef SLOAD
#undef SWRITE
}
template <class T>
__device__ __forceinline__ void attn_store(char* lds, const f32x16 (&o)[4], float l_reg, T* Ow, int ldo) {
    int tid_ = threadIdx.x; asm volatile("" : "+v"(tid_));
    const int tid = tid_, lane = tid & 63, r32 = lane & 31, hi = lane >> 5; const int wid = __builtin_amdgcn_readfirstlane(tid >> 6);
    float* li_l = (float*)(lds + L_WS) + wid * 64;
    if (hi == 0) li_l[r32] = l_reg; asm volatile("s_waitcnt lgkmcnt(0)" ::: "memory");
#pragma unroll
    for (int r = 0; r < 16; ++r) { const int orow = crow(r, hi); const float lv = li_l[orow]; const float rl = lv > 0.f ? __builtin_amdgcn_rcpf(lv) : 0.f;
#pragma unroll
        for (int d0 = 0; d0 < 4; ++d0) { const float v = o[d0][r] * rl;
            if constexpr (sizeof(T) == 4) { Ow[(size_t)orow * ldo + d0 * 32 + r32] = v; }
            else { const float vn = __shfl_xor(v, 1); if ((r32 & 1) == 0) *(unsigned*)(Ow + (size_t)orow * ldo + d0 * 32 + r32) = cvtpk(v, vn); } } }
    asm volatile("s_waitcnt lgkmcnt(0)" ::: "memory");
}
#undef KSWZ
#undef SBAR
}

__device__ __forceinline__ void attn_phase(Frame& F, char* lds, const bf16* QKV, bf16* Y, float* PB, float* PML, const float* sinks, const float* relb) {
    int tid_ = threadIdx.x; asm volatile("" : "+v"(tid_));
    const int wid = __builtin_amdgcn_readfirstlane(tid_ >> 6), lane = tid_ & 63;
    att::f32x16 o[4]; float m_reg, l_reg;
    for (int w = F.vcu; w < 256; w += F.G) { const int h = w >> 6, jj = w & 63;
#pragma unroll 1
        for (int half = 0; half < 2; ++half) { const int j = half ? 63 - jj : jj; const int comp = wid >> 2, row0 = 128 * j + 32 * (wid & 3), cw = 2 * j + ((wid & 3) >> 1);
            att::UnitArgs U; U.Q = QKV + O_QB + (size_t)h * HS + (size_t)row0 * 128 + comp * 64; U.K = QKV + O_KB + (size_t)h * HS; U.V = QKV + O_VB + (size_t)h * HS;
            U.t_lo = half ? j + 1 : 0; U.t_hi = half ? 2 * j + 2 : j + 1; U.a_lo = 0; U.a_hi = cw; U.koff = comp * 128; U.qpos0 = 0; U.m0 = -1e30f; U.l0 = 0.f;
            att::attn_unit<1>(lds, U, o, m_reg, l_reg);
            const size_t pidx = ((size_t)(half * 4 + h) * 2 + comp) * S + row0;
            att::attn_store<float>(lds, o, l_reg, PB + pidx * 128, 128);
            if (lane < 32) { float* ml = PML + (pidx + lane) * 2; ml[0] = m_reg; ml[1] = l_reg; } } }
    for (int w = F.vcu; w < 128; w += F.G) { const int h = w >> 5, j = w & 31; const int cw = 4 * j + (wid >> 1), row0 = 64 * cw + 32 * (wid & 1);
        { float* bt = (float*)(lds + att::L_BIAS); for (int i = tid_; i < 513; i += NWAVES * 64) bt[i] = relb[h * 513 + i] * LOG2E; }
        att::UnitArgs U; U.Q = QKV + O_QC + (size_t)h * HS + (size_t)row0 * 128; U.K = QKV + O_KC + (size_t)h * HS; U.V = QKV + O_VC + (size_t)h * HS;
        U.t_lo = 4 * j >= 8 ? 4 * j - 8 : 0; U.t_hi = 4 * j + 4; U.a_lo = cw - 8; U.a_hi = cw; U.koff = 0; U.qpos0 = row0; U.m0 = -1e30f; U.l0 = 0.f;
        att::attn_unit<2>(lds, U, o, m_reg, l_reg);
        att::attn_store<bf16>(lds, o, l_reg, Y + (size_t)row0 * DM + 1536 + h * 128, DM); }
    for (int w = F.vcu; w < 256; w += F.G) { const int kvh = w >> 7, c = w & 127; const int hq = kvh * 4 + (wid >> 1), row0 = 64 * c + 32 * (wid & 1);
        att::UnitArgs U; U.Q = QKV + O_QA + (size_t)hq * HS + (size_t)row0 * 128; U.K = QKV + O_KA + (size_t)kvh * HS; U.V = QKV + O_VA + (size_t)kvh * HS;
        U.t_lo = c >= 2 ? c - 2 : 0; U.t_hi = c + 1; U.a_lo = 0; U.a_hi = c; U.koff = 0; U.qpos0 = 0; U.m0 = sinks[hq] * LOG2E; U.l0 = 1.0f;
        att::attn_unit<0>(lds, U, o, m_reg, l_reg);
        att::attn_store<bf16>(lds, o, l_reg, Y + (size_t)row0 * DM + hq * 128, DM); }
}
__device__ __forceinline__ void attn_b_combine(Frame& F, const float* PB, const float* PML, bf16* Y, const float* lq1, const float* lk1, const float* lq2, const float* lk2, const float* subg, float lam_init) {
    int lane_ = F.lane; asm volatile("" : "+v"(lane_));
    const int gw = F.vcu * NWAVES + F.wave, NGW = F.G * NWAVES, lane = lane_;
    const float lam = expf(wave_sum(lq1[lane] * lk1[lane])) - expf(wave_sum(lq2[lane] * lk2[lane])) + lam_init;
    const float g0 = subg[2 * lane], g1 = subg[2 * lane + 1];
    for (int it = gw; it < 4 * S; it += NGW) { const int s = it >> 2, h = it & 3;
        float oc[2][2];
#pragma unroll
        for (int comp = 0; comp < 2; ++comp) {
            const size_t i0 = ((size_t)(0 * 4 + h) * 2 + comp) * S + s, i1 = ((size_t)(1 * 4 + h) * 2 + comp) * S + s;
            const f32x2 ml0 = *(const f32x2*)(PML + i0 * 2), ml1 = *(const f32x2*)(PML + i1 * 2);
            const float M = fmaxf(ml0[0], ml1[0]); const float w0 = ml0[1] * __builtin_amdgcn_exp2f(ml0[0] - M), w1 = ml1[1] * __builtin_amdgcn_exp2f(ml1[0] - M);
            const float inv = 1.0f / (w0 + w1);
            const f32x2 a = *(const f32x2*)(PB + i0 * 128 + 2 * lane), b = *(const f32x2*)(PB + i1 * 128 + 2 * lane);
            oc[comp][0] = (w0 * a[0] + w1 * b[0]) * inv; oc[comp][1] = (w0 * a[1] + w1 * b[1]) * inv; }
        const float d0 = oc[0][0] - lam * oc[1][0], d1 = oc[0][1] - lam * oc[1][1];
        const float r = 1.0f / sqrtf(wave_sum(d0 * d0 + d1 * d1) * (1.f / 128.f) + LN_EPS) * (1.0f - lam_init);
        *(unsigned*)(Y + (size_t)s * DM + 1024 + h * 128 + 2 * lane) = pk2(d0 * r * g0, d1 * r * g1); }
}
__global__ void __launch_bounds__(NWAVES * 64, 2) mk_fwd(Args args) {
    extern __shared__ __attribute__((aligned(16))) unsigned char lds[];
    Frame F;
    F.lds = (LAS unsigned char*)lds; F.MISC = (volatile LAS unsigned*)(F.lds + MISC_OFF);
    F.tid = threadIdx.x; F.lane = F.tid & 63; F.wave = __builtin_amdgcn_readfirstlane(F.tid >> 6);
    F.G = gridDim.x; { const int bx = blockIdx.x; F.vcu = (F.G % 8 == 0) ? (bx % 8) * (F.G / 8) + bx / 8 : bx; }
    unsigned char* ws = args.ws; F.ctl = (gu32*)(ws + WS_CTL);
    for (int u = F.tid; u < (LDS_BYTES - LDSCTL_OFF) / 4; u += NWAVES * 64) ((LAS unsigned*)(F.lds + LDSCTL_OFF))[u] = 0u;
    __syncthreads();
    XcdBarrier bar = xcd_barrier_post((unsigned*)(F.ctl + CW_BAR), F.MISC + 8);
#define GRID_BAR() xcd_barrier_t<false>(bar)
#define PHASE_VARS GAS unsigned char* wsp = (GAS unsigned char*)ws; GAS float* outg = (GAS float*)args.out; int cbx = (int)blockIdx.x, Gx = F.G; asm volatile("" : "+s"(wsp), "+s"(outg), "+s"(cbx), "+s"(Gx)); float* outp = (float*)outg; \
    bf16* XB = (bf16*)(wsp + WS_XB); bf16* QKV = (bf16*)(wsp + WS_QKV); bf16* G = (bf16*)(wsp + WS_G); bf16* Y = (bf16*)(wsp + WS_Y); bf16* MIXB = (bf16*)(wsp + WS_MIXB); bf16* FB = (bf16*)(wsp + WS_F); \
    float* CSA = (float*)(wsp + WS_CSA); float* CSB = (float*)(wsp + WS_CSB); float* V32 = (float*)(wsp + WS_V32); float* MIX32 = (float*)(wsp + WS_MIX32); \
    const unsigned char* Wl = (const unsigned char*)(wsp + WS_W + (size_t)l * WL_SIZE); \
    (void)XB; (void)QKV; (void)G; (void)Y; (void)MIXB; (void)FB; (void)CSA; (void)CSB; (void)V32; (void)MIX32; (void)Wl; (void)outp; (void)cbx; (void)Gx

    p0_prologue(F, args);
    xcd_barrier_t<true>(bar);

    for (int l = 0; l < DEPTH; ++l) {
        { PHASE_VARS;
          { pg8::Gemm g{XB, (const bf16*)(Wl + WL_W1), DM, DM}; pg8::StaticOrder So; So.init(S, INW, Gx, cbx);
            EpiIn E{QKV, CSA, CSB}; pg8::gemm_phase<EpiIn, pg8::StaticOrder, true>(F.lds, g, So, E); }
          { pg8::Gemm g{XB, (const bf16*)(Wl + WL_W1 + (size_t)INW * DM * 2), DM, DM}; pg8::StaticOrder So; So.init(S, GW, Gx, cbx);
            EpiGate E{G, args.in[13] + (size_t)l * GW}; pg8::gemm_phase<EpiGate, pg8::StaticOrder, true>(F.lds, g, So, E); } }
        GRID_BAR();
        { PHASE_VARS; attn_phase(F, (char*)lds, QKV, Y, (float*)(wsp + WS_PB), (float*)(wsp + WS_PML), args.in[2] + l * 8, args.in[8] + (size_t)l * 4 * 513); }
        GRID_BAR();
        { PHASE_VARS; const float lam_init = 0.8f - 0.6f * expf(-0.3f * (float)l);
          attn_b_combine(F, (const float*)(wsp + WS_PB), (const float*)(wsp + WS_PML), Y, args.in[3] + l * 64, args.in[4] + l * 64, args.in[5] + l * 64, args.in[6] + l * 64, args.in[7] + l * 128, lam_init); }
        GRID_BAR();
        { PHASE_VARS; pg8::StaticOrder So; So.init(S, DM, Gx, cbx);
          { pg8::Gemm g{Y, (const bf16*)(Wl + WL_BA), DM, 1024}; EpiBr<0> E{G, 0, 0, MIX32, MIXB}; pg8::gemm_phase<EpiBr<0>, pg8::StaticOrder, false>(F.lds, g, So, E); }
          { pg8::Gemm g{Y + 1024, (const bf16*)(Wl + WL_BB), DM, 512}; EpiBr<1> E{G, 2048, 0, MIX32, MIXB}; pg8::gemm_phase<EpiBr<1>, pg8::StaticOrder, false>(F.lds, g, So, E); }
          { pg8::Gemm g{Y + 1536, (const bf16*)(Wl + WL_BC), DM, 512}; EpiBr<2> E{G, 4096, 0, MIX32, MIXB}; pg8::gemm_phase<EpiBr<2>, pg8::StaticOrder, false>(F.lds, g, So, E); } }
        GRID_BAR();
        { PHASE_VARS; const float* xres = (l == 0) ? args.in[0] : (const float*)outp;
          pg8::Gemm g{MIXB, (const bf16*)(Wl + WL_WO), DM, DM}; pg8::StaticOrder So; So.init(S, DM, Gx, cbx);
          EpiRes E{xres, V32}; pg8::gemm_phase<EpiRes, pg8::StaticOrder, false>(F.lds, g, So, E); }
        GRID_BAR();
        { PHASE_VARS; ln_phase(F, V32, args.in[15] + (size_t)l * DM, args.in[16] + (size_t)l * DM, outp, XB); }
        GRID_BAR();
        { PHASE_VARS; pg8::Gemm g{XB, (const bf16*)(Wl + WL_F1), DM, DM}; pg8::StaticOrder So; So.init(S, 2 * FH, Gx, cbx);
          EpiSwiGLU E{FB}; pg8::gemm_phase<EpiSwiGLU, pg8::StaticOrder, true>(F.lds, g, So, E); }
        GRID_BAR();
        { PHASE_VARS; pg8::Gemm g{FB, (const bf16*)(Wl + WL_F2), FH, FH}; pg8::StaticOrder So; So.init(S, DM, Gx, cbx);
          EpiRes E{outp, V32}; pg8::gemm_phase<EpiRes, pg8::StaticOrder, false>(F.lds, g, So, E); }
        GRID_BAR();
        { PHASE_VARS; ln_phase(F, V32, args.in[19] + (size_t)l * DM, args.in[20] + (size_t)l * DM, outp, XB); }
        GRID_BAR();
    }
}

extern "C" void kernel_launch(void* const* d_in, const int* in_sizes, int n_in, void* d_out, int out_size, void* d_ws, size_t ws_size, hipStream_t stream) {
    static int grid = 0;
    if (grid == 0) {
        if (n_in != 21 || out_size != S * DM || ws_size < WS_END) { fprintf(stderr, "kernel_launch: unexpected shapes (n_in %d out %d ws %zu need %zu)\n", n_in, out_size, ws_size, (size_t)WS_END); grid = -1; return; }
        int dev = 0, cus = 0, per_cu = 0;
        if (hipGetDevice(&dev) != hipSuccess || hipDeviceGetAttribute(&cus, hipDeviceAttributeMultiprocessorCount, dev) != hipSuccess) { grid = -1; return; }
        if (hipFuncSetAttribute((const void*)mk_fwd, hipFuncAttributeMaxDynamicSharedMemorySize, LDS_BYTES) != hipSuccess) { fprintf(stderr, "kernel_launch: hipFuncSetAttribute failed\n"); grid = -1; return; }
        if (hipOccupancyMaxActiveBlocksPerMultiprocessor(&per_cu, (const void*)mk_fwd, NWAVES * 64, LDS_BYTES) != hipSuccess || per_cu < 1) fprintf(stderr, "kernel_launch: occupancy query reports %d\n", per_cu);
        (void)hipGetLastError();
        grid = cus;
    }
    if (grid < 0) return;
    if (hipMemsetAsync((char*)d_ws + WS_CTL, 0, CTL_ZERO_BYTES, stream) != hipSuccess) return;
    Args a{};
    for (int i = 0; i < 21; ++i) a.in[i] = (const float*)d_in[i];
    a.out = (float*)d_out; a.ws = (unsigned char*)d_ws;
    hipLaunchKernelGGL(mk_fwd, dim3(grid), dim3(NWAVES * 64), LDS_BYTES, stream, a);
}
```

```cpp
#include <hip/hip_runtime.h>
#include <cstdio>
#include <cstdint>
#include <cmath>

namespace pg8 {
#define PG8_LAS __attribute__((address_space(3)))
typedef unsigned short bf16_t;
typedef short bf16x8 __attribute__((ext_vector_type(8)));
typedef float f32x4 __attribute__((ext_vector_type(4)));
typedef unsigned u32x4 __attribute__((ext_vector_type(4)));
typedef unsigned u32x2 __attribute__((ext_vector_type(2)));
constexpr int BM = 256, BK = 64, HALF = 128, HTB = HALF * BK * 2  , STAGE_BYTES = 8 * HTB, NXCD = 8, WGM = 8;

__host__ __device__ __forceinline__ int lds_byte(int r, int c) { const int st = (r >> 4) * 2 + (c >> 5), rr = r & 15, cc = c & 31, ob = rr * 64 + cc * 2; return st * 1024 + (ob ^ (((ob >> 9) & 1) << 5)); }
__host__ __device__ __forceinline__ void stage_rc(int b, int& R, int& C) { const int st = b / 1024, sb = b % 1024, swz = sb ^ (((sb >> 9) & 1) << 5); R = (st >> 1) * 16 + swz / 64; C = (st & 1) * 32 + (swz % 64) / 2; }

struct Unit { int pm, pn; };
struct Gemm { const bf16_t* A; const bf16_t* Bt; int lda, K; };

struct StaticOrder {
    int nM, nN, nwg, G, c;
    __host__ __device__ void init(int M, int N, int G_, int c_) { nM = M / BM; nN = N / BM; nwg = nM * nN; G = G_; c = c_; }
    __host__ __device__ bool next(int i, Unit& u) const {
        const long L = (long)i * G + c; if (L >= nwg) return false;
        int wgid = (int)L; { const int q = nwg / NXCD, r = nwg % NXCD, xcd = wgid % NXCD, off = wgid / NXCD; wgid = (xcd < r ? xcd * (q + 1) : r * (q + 1) + (xcd - r) * q) + off; }
        const int nig = WGM * nN, gid = wgid / nig, fm = gid * WGM, gsz = (nM - fm) < WGM ? (nM - fm) : WGM;
        u.pm = fm + ((wgid % nig) % gsz); u.pn = (wgid % nig) / gsz; return true;
    }
    __device__ __forceinline__ void a_ready(const Unit&) const {}
    __device__ __forceinline__ void done(const Unit&) const {}
};

template <class Epi, class Sched, bool ALIGN_EPI>
__device__ __forceinline__ void gemm_phase(PG8_LAS unsigned char* lds, const Gemm g, const Sched& S, const Epi& E) {
    int tid_ = threadIdx.x; asm volatile("" : "+v"(tid_));
    const int tid = tid_, wid = __builtin_amdgcn_readfirstlane(tid >> 6), lane = tid & 63, wr = wid >> 2, wc = wid & 3, fr = lane & 15, fq = lane >> 4;
    const int K = g.K, lda = g.lda, nt = K / BK;
    unsigned voffA[2], voffB[2];
#pragma unroll
    for (int i = 0; i < 2; ++i) { int R, C; stage_rc(tid * 16 + i * 8192, R, C);
        voffA[i] = (unsigned)(R * lda + C) * 2u; voffB[i] = (unsigned)(R * K + C) * 2u; }
    const size_t kstep = (size_t)(BK * 2);
    const size_t hstepA = (size_t)HALF * lda * 2, hstepB = (size_t)HALF * K * 2;
    const size_t tstepA = 2 * hstepA, tstepB = 2 * hstepB;
    const unsigned ldsw = (unsigned)wid * 1024u;
    const int aoff = lds_byte(wr * 64 + fr, fq * 8), boff = lds_byte(wc * 32 + fr, fq * 8);
#define PG8_SA(b, h) (((b) * 2 + (h)) * HTB)
#define PG8_SB(b, h) ((4 + (b) * 2 + (h)) * HTB)
#define PG8_STAGE(bufoff, gbase, voff) do { _Pragma("unroll") for (int _i = 0; _i < 2; ++_i) \
        __builtin_amdgcn_global_load_lds((const unsigned*)((const char*)(gbase) + (voff)[_i]), (PG8_LAS unsigned*)(lds + (bufoff) + ldsw + _i * 8192), 16, 0, 0); } while (0)
#define PG8_LDA(dst, b, h) do { _Pragma("unroll") for (int m = 0; m < 4; ++m) _Pragma("unroll") for (int k = 0; k < 2; ++k) dst[m][k] = *(const PG8_LAS bf16x8*)(lds + PG8_SA(b, h) + aoff + m * 2048 + k * 1024); } while (0)
#define PG8_LDB(dst, b, h) do { _Pragma("unroll") for (int n = 0; n < 2; ++n) _Pragma("unroll") for (int k = 0; k < 2; ++k) dst[n][k] = *(const PG8_LAS bf16x8*)(lds + PG8_SB(b, h) + boff + n * 2048 + k * 1024); } while (0)
#define PG8_MMA(ai, bj, At, Bt) do { __builtin_amdgcn_s_setprio(1); _Pragma("unroll") for (int m = 0; m < 4; ++m) _Pragma("unroll") for (int n = 0; n < 2; ++n) _Pragma("unroll") for (int k = 0; k < 2; ++k) \
        acc[ai][bj][m][n] = __builtin_amdgcn_mfma_f32_16x16x32_bf16(Bt[n][k], At[m][k], acc[ai][bj][m][n], 0, 0, 0); __builtin_amdgcn_s_setprio(0); } while (0)
#define PG8_WAIT_V(n) asm volatile("s_waitcnt vmcnt(" #n ")" ::: "memory")
#define PG8_WAIT_L(n) asm volatile("s_waitcnt lgkmcnt(" #n ")" ::: "memory")
#define PG8_BAR __builtin_amdgcn_s_barrier()
#define PG8_SCHED __builtin_amdgcn_sched_barrier(0)
    Unit cur, nxt; int ui = 0;
    if (!S.next(0, cur)) return;
    f32x4 acc[2][2][4][2];
#pragma unroll
    for (int a = 0; a < 2; ++a)
#pragma unroll
        for (int b = 0; b < 2; ++b)
#pragma unroll
            for (int m = 0; m < 4; ++m)
#pragma unroll
                for (int n = 0; n < 2; ++n) acc[a][b][m][n] = (f32x4){0.f, 0.f, 0.f, 0.f};
    bf16x8 At[4][2], B0[2][2], B1[2][2];
    const char* cA = (const char*)g.A + (size_t)cur.pm * tstepA; const char* cB = (const char*)g.Bt + (size_t)cur.pn * tstepB;
    S.a_ready(cur);
    PG8_STAGE(PG8_SB(0, 0), cB, voffB); PG8_STAGE(PG8_SB(0, 1), cB + hstepB, voffB); PG8_STAGE(PG8_SA(0, 0), cA, voffA); PG8_STAGE(PG8_SA(0, 1), cA + hstepA, voffA);
    if (wr == 1) PG8_BAR;
    PG8_WAIT_V(2); PG8_BAR;
    PG8_STAGE(PG8_SB(1, 0), cB + kstep, voffB); PG8_STAGE(PG8_SA(1, 0), cA + kstep, voffA); PG8_STAGE(PG8_SB(1, 1), cB + hstepB + kstep, voffB);
    PG8_WAIT_V(6); PG8_BAR;
    for (;;) {
        const bool has_next = S.next(ui + 1, nxt);
        const char* nA = has_next ? (const char*)g.A + (size_t)nxt.pm * tstepA : cA; const char* nB = has_next ? (const char*)g.Bt + (size_t)nxt.pn * tstepB : cB;
        for (int t = 0; t < nt; t += 2) {
            const bool last = (t == nt - 2);
            const char* a1 = cA + (size_t)(t + 1) * kstep;
            const char* a2 = last ? nA : cA + (size_t)(t + 2) * kstep; const char* b2 = last ? nB : cB + (size_t)(t + 2) * kstep;
            const char* a3 = a2 + kstep; const char* b3 = b2 + kstep;
            if (last && has_next) S.a_ready(nxt);
            if constexpr (Epi::KSCALE) { if (E.kscale_at(t)) E.kscale(acc, cur, t, wr, wc, fr, fq); }
            PG8_LDB(B0, 0, 0); PG8_LDB(B1, 0, 1); PG8_SCHED; PG8_LDA(At, 0, 0); PG8_STAGE(PG8_SA(1, 1), a1 + hstepA, voffA);
            PG8_WAIT_V(8); PG8_WAIT_L(0); PG8_BAR; PG8_MMA(0, 0, At, B0); PG8_MMA(0, 1, At, B1); PG8_BAR; PG8_SCHED;
            PG8_LDA(At, 0, 1); PG8_STAGE(PG8_SB(0, 0), b2, voffB); PG8_STAGE(PG8_SB(0, 1), b2 + hstepB, voffB); PG8_STAGE(PG8_SA(0, 0), a2, voffA);
            PG8_WAIT_V(8); PG8_WAIT_L(0); PG8_BAR; PG8_MMA(1, 0, At, B0); PG8_MMA(1, 1, At, B1); PG8_BAR; PG8_SCHED;
            PG8_LDB(B0, 1, 0); PG8_LDB(B1, 1, 1); PG8_SCHED; PG8_LDA(At, 1, 0); PG8_STAGE(PG8_SA(0, 1), a2 + hstepA, voffA);
            PG8_WAIT_V(8); PG8_WAIT_L(0); PG8_BAR; PG8_MMA(0, 0, At, B0); PG8_MMA(0, 1, At, B1); PG8_BAR; PG8_SCHED;
            PG8_LDA(At, 1, 1); PG8_STAGE(PG8_SB(1, 0), b3, voffB); PG8_STAGE(PG8_SB(1, 1), b3 + hstepB, voffB); PG8_STAGE(PG8_SA(1, 0), a3, voffA);
            PG8_WAIT_V(8); PG8_WAIT_L(0); PG8_BAR; PG8_MMA(1, 0, At, B0); PG8_MMA(1, 1, At, B1); PG8_BAR; PG8_SCHED;
        }
        if constexpr (ALIGN_EPI) { if (wr == 0) PG8_BAR; }
        if constexpr (!Epi::AFTER_DRAIN) { E(acc, cur, wr, wc, fr, fq); S.done(cur); }
        if (!has_next) break;
#pragma unroll
        for (int a = 0; a < 2; ++a)
#pragma unroll
            for (int b = 0; b < 2; ++b)
#pragma unroll
                for (int m = 0; m < 4; ++m)
#pragma unroll
                    for (int n = 0; n < 2; ++n) acc[a][b][m][n] = (f32x4){0.f, 0.f, 0.f, 0.f};
        cur = nxt; cA = nA; cB = nB; ++ui;
        if constexpr (ALIGN_EPI) { if (wr == 1) PG8_BAR; }
    }
    PG8_WAIT_V(0);
    if constexpr (!ALIGN_EPI) { if (wr == 0) PG8_BAR; }
    PG8_BAR;
    if constexpr (Epi::AFTER_DRAIN) { E.fused(acc, cur, wr, wc, fr, fq, lds, wid, lane); S.done(cur); }
#undef PG8_SA
#undef PG8_SB
#undef PG8_STAGE
#undef PG8_LDA
#undef PG8_LDB
#undef PG8_MMA
#undef PG8_WAIT_V
#undef PG8_WAIT_L
#undef PG8_BAR
#undef PG8_SCHED
}
}

typedef unsigned short bf16;
typedef short bf16x8 __attribute__((ext_vector_type(8)));
typedef float f32x4 __attribute__((ext_vector_type(4)));
typedef float f32x2 __attribute__((ext_vector_type(2)));
typedef unsigned u32x4 __attribute__((ext_vector_type(4)));
typedef unsigned u32x2 __attribute__((ext_vector_type(2)));
#define GAS __attribute__((address_space(1)))
#define LAS __attribute__((address_space(3)))
typedef GAS unsigned gu32;

constexpr int S = 8192, DM = 2048, DEPTH = 4, INW = 4608, GW = 6144, FH = 5632;
constexpr float LN_EPS = 1e-5f;
constexpr float ALPHA = 1.6817928305074290f;
constexpr float LOG2E = 1.4426950408889634f;
constexpr float C2_A = 0.08838834764831845f * LOG2E, C2_B = 0.125f * LOG2E;
constexpr size_t MiB = 1u << 20;
constexpr int NWAVES = 8;

constexpr size_t WL_W1 = 0;
constexpr size_t WL_BA = WL_W1 + (size_t)10752 * 2048 * 2;
constexpr size_t WL_BB = WL_BA + (size_t)2048 * 1024 * 2;
constexpr size_t WL_BC = WL_BB + (size_t)2048 * 512 * 2;
constexpr size_t WL_WO = WL_BC + (size_t)2048 * 512 * 2;
constexpr size_t WL_F1 = WL_WO + (size_t)2048 * 2048 * 2;
constexpr size_t WL_F2 = WL_F1 + (size_t)11264 * 2048 * 2;
constexpr size_t WL_SIZE = WL_F2 + (size_t)2048 * 5632 * 2;
constexpr size_t WS_CTL = 0, CTL_ZERO_BYTES = 1 * MiB;
constexpr size_t WS_W = 1 * MiB;
constexpr size_t WS_XB = WS_W + 4 * WL_SIZE;
constexpr size_t WS_QKV = WS_XB + (size_t)S * DM * 2;
constexpr size_t WS_G = WS_QKV + (size_t)S * INW * 2;
constexpr size_t WS_Y = WS_G + (size_t)S * GW * 2;
constexpr size_t WS_MIXB = WS_Y + (size_t)S * DM * 2;
constexpr size_t WS_F = WS_MIXB + (size_t)S * DM * 2;
constexpr size_t WS_CSA = WS_F + (size_t)S * FH * 2;
constexpr size_t WS_CSB = WS_CSA + (size_t)S * 64 * 2 * 4;
constexpr size_t WS_V32 = WS_CSB + (size_t)S * 32 * 2 * 4;
constexpr size_t WS_MIX32 = WS_V32 + (size_t)S * DM * 4;
constexpr size_t WS_PB = WS_MIX32 + (size_t)S * DM * 4;
constexpr size_t WS_PML = WS_PB + (size_t)16 * S * 128 * 4;
constexpr size_t WS_END = WS_PML + (size_t)16 * S * 2 * 4;
constexpr size_t HS = (size_t)S * 128;
constexpr size_t O_QA = 0, O_KA = 8 * HS, O_VA = 10 * HS, O_QB = 12 * HS, O_KB = 16 * HS, O_VB = 20 * HS, O_QC = 24 * HS, O_KC = 28 * HS, O_VC = 32 * HS;
constexpr int CW_BAR = 4096;
constexpr int RING_BYTES = 131072, LDSCTL_OFF = RING_BYTES, MISC_OFF = LDSCTL_OFF + 320, LDS_BYTES = 147456;

__device__ __forceinline__ unsigned f2bf(float f) { unsigned u = __builtin_bit_cast(unsigned, f); return (u + 0x7fffu + ((u >> 16) & 1u)) >> 16; }
__device__ __forceinline__ unsigned pk2(float lo, float hi) { return f2bf(lo) | (f2bf(hi) << 16); }
__device__ __forceinline__ float bf2f(unsigned short b) { return __builtin_bit_cast(float, (unsigned)b << 16); }
__device__ __forceinline__ u32x2 pk4(f32x4 v) { u32x2 o; o.x = pk2(v[0], v[1]); o.y = pk2(v[2], v[3]); return o; }
__device__ __forceinline__ f32x4 unpk4(u32x2 w) { f32x4 g; g[0] = bf2f(w.x & 0xffff); g[1] = bf2f(w.x >> 16); g[2] = bf2f(w.y & 0xffff); g[3] = bf2f(w.y >> 16); return g; }
__device__ __forceinline__ float wave_sum(float v) {
#pragma unroll
    for (int o = 1; o < 64; o <<= 1) v += __shfl_xor(v, o);
    return v;
}
__device__ __forceinline__ float wave_max(float v) {
#pragma unroll
    for (int o = 1; o < 64; o <<= 1) v = fmaxf(v, __shfl_xor(v, o));
    return v;
}
__device__ __forceinline__ float fsigmoid(float z) { return __builtin_amdgcn_rcpf(1.0f + __builtin_amdgcn_exp2f(-z * LOG2E)); }

#define XB_TMO      128
#define XB_XCNT(j)  (256  + 64 * (j))
#define XB_XSUB(j)  (1280 + 64 * (j))
#define XB_XGEN(j)  (2304 + 64 * (j))
#define XB_TOP      3328
#define XB_TOPGEN   3392
#define XCD_BAR_WORDS 3456
#define XB_SPIN_CAP (1u << 18)
__device__ __forceinline__ unsigned xb_ld(unsigned* p)              { return __hip_atomic_load(p, __ATOMIC_RELAXED, __HIP_MEMORY_SCOPE_AGENT); }
__device__ __forceinline__ unsigned xb_add(unsigned* p, unsigned v) { return __hip_atomic_fetch_add(p, v, __ATOMIC_RELAXED, __HIP_MEMORY_SCOPE_AGENT); }
__device__ __forceinline__ unsigned xb_xcc_id() { return (unsigned)__builtin_amdgcn_s_getreg((3 << 11) | 20) & 0xFu; }
#define XB_SPIN(cond, bar) do { unsigned _sp = 0; while (cond) { __builtin_amdgcn_s_sleep(1); \
    if ((++_sp & 255u) == 0u) { if (xb_ld(&(bar)[XB_TMO])) break; if (_sp > XB_SPIN_CAP) { atomicAdd(&(bar)[XB_TMO], 1u); break; } } } } while (0)
struct XcdBarrier { unsigned* bar; unsigned x; volatile LAS unsigned* st; };
__device__ __forceinline__ XcdBarrier xcd_barrier_post(unsigned* bar, volatile LAS unsigned* st) {
    XcdBarrier b; b.bar = bar; b.x = xb_xcc_id(); b.st = st;
    if (threadIdx.x == 0) (void)xb_add(&bar[XB_XCNT(b.x)], 1u);
    return b;
}
__device__ __forceinline__ void xcd_barrier_complete(unsigned* bar, unsigned x, unsigned& nloc, unsigned& nx) {
    const unsigned G = gridDim.x * gridDim.y * gridDim.z;
    unsigned sum, cnt, mine, sp = 0u;
    for (;;) {
        sum = 0u; cnt = 0u; mine = 0u;
#pragma unroll
        for (unsigned j = 0; j < 16; ++j) { const unsigned c = xb_ld(&bar[XB_XCNT(j)]); sum += c; cnt += (c > 0u) ? 1u : 0u; mine = (j == x) ? c : mine; }
        if (sum == G) break;
        __builtin_amdgcn_s_sleep(1);
        if ((++sp & 255u) == 0u) { if (xb_ld(&bar[XB_TMO])) break; if (sp > XB_SPIN_CAP) { atomicAdd(&bar[XB_TMO], 1u); break; } }
    }
    nloc = mine > 0u ? mine : 1u; nx = cnt > 0u ? cnt : 1u;
}
template <bool FIRST>
__device__ __forceinline__ void xcd_barrier_t(const XcdBarrier& b) {
    asm volatile("s_waitcnt vmcnt(0)" ::: "memory");
    __syncthreads();
    if (threadIdx.x == 0) {
        GAS unsigned* barg = (GAS unsigned*)b.bar; unsigned x = b.x;
        asm volatile("" : "+s"(barg), "+s"(x)); unsigned* bar = (unsigned*)barg;
        __builtin_amdgcn_s_waitcnt(0);
        unsigned nloc = b.st[0], nx = b.st[1];
        if (FIRST) { if (nloc == 0u) { xcd_barrier_complete(bar, x, nloc, nx); b.st[0] = nloc; b.st[1] = nx; } }
        else { nloc = nloc ? nloc : 1u; nx = nx ? nx : 1u; }
        const unsigned old = xb_add(&bar[XB_XSUB(x)], 1u);
        const unsigned gen = old / nloc;
        if (old + 1u == (gen + 1u) * nloc) {
            __builtin_amdgcn_fence(__ATOMIC_RELEASE, "agent");
            asm volatile("s_waitcnt vmcnt(0)" ::: "memory");
            const unsigned og = xb_add(&bar[XB_TOP], 1u);
            const unsigned tg = og / nx;
            if (og + 1u == (tg + 1u) * nx) xb_add(&bar[XB_TOPGEN], 1u);
            else XB_SPIN(xb_ld(&bar[XB_TOPGEN]) == tg, bar);
            __builtin_amdgcn_fence(__ATOMIC_ACQUIRE, "agent");
            xb_add(&bar[XB_XGEN(x)], 1u);
            asm volatile("s_waitcnt vmcnt(0)" ::: "memory");
        } else {
            XB_SPIN(xb_ld(&bar[XB_XGEN(x)]) == gen, bar);
            __builtin_amdgcn_fence(__ATOMIC_ACQUIRE, "agent");
            asm volatile("s_waitcnt vmcnt(0)" ::: "memory");
        }
    }
    __syncthreads();
}

using pg8::Unit;
struct EpiIn { bf16* QKV; const float* csa; const float* csb;
    static constexpr bool PERM = false, KSCALE = false, AFTER_DRAIN = false;
    __device__ __forceinline__ void operator()(const f32x4 (&acc)[2][2][4][2], const Unit& u, int wr, int wc, int fr_, int fq_) const {
        int fr = fr_, fq = fq_; asm volatile("" : "+v"(fr), "+v"(fq));
#pragma unroll
        for (int bj = 0; bj < 2; ++bj) { const int hh = u.pn * 2 + bj; bf16* hb = QKV + (size_t)hh * HS;
            if (hh < 10) {
                const int d0 = 16 * wc + 4 * fq; const float qs = hh < 8 ? C2_A : 1.0f;
#pragma unroll
                for (int ai = 0; ai < 2; ++ai)
#pragma unroll
                    for (int m = 0; m < 4; ++m) { const int s = u.pm * 256 + ai * 128 + wr * 64 + m * 16 + fr; const f32x4 x0 = acc[ai][bj][m][0] * qs, x1 = acc[ai][bj][m][1] * qs;
                        const f32x4 cs0 = *(const f32x4*)(csa + ((size_t)s * 64 + d0) * 2), cs1 = *(const f32x4*)(csa + ((size_t)s * 64 + d0) * 2 + 4);
                        const f32x4 c = {cs0[0], cs0[2], cs1[0], cs1[2]}, sn = {cs0[1], cs0[3], cs1[1], cs1[3]};
                        const f32x4 o0 = x0 * c - x1 * sn, o1 = x1 * c + x0 * sn;
                        *(u32x2*)(hb + (size_t)s * 128 + d0) = pk4(o0); *(u32x2*)(hb + (size_t)s * 128 + d0 + 64) = pk4(o1); }
            } else if (hh >= 12 && hh < 20) {
                const int dd = 16 * (wc & 1) + 4 * fq, cb = 64 * (wc >> 1); const float qs = hh < 16 ? C2_B : 1.0f;
#pragma unroll
                for (int ai = 0; ai < 2; ++ai)
#pragma unroll
                    for (int m = 0; m < 4; ++m) { const int s = u.pm * 256 + ai * 128 + wr * 64 + m * 16 + fr; const f32x4 x0 = acc[ai][bj][m][0] * qs, x1 = acc[ai][bj][m][1] * qs;
                        const f32x4 cs0 = *(const f32x4*)(csb + ((size_t)s * 32 + dd) * 2), cs1 = *(const f32x4*)(csb + ((size_t)s * 32 + dd) * 2 + 4);
                        const f32x4 c = {cs0[0], cs0[2], cs1[0], cs1[2]}, sn = {cs0[1], cs0[3], cs1[1], cs1[3]};
                        const f32x4 o0 = x0 * c - x1 * sn, o1 = x1 * c + x0 * sn;
                        *(u32x2*)(hb + (size_t)s * 128 + cb + dd) = pk4(o0); *(u32x2*)(hb + (size_t)s * 128 + cb + dd + 32) = pk4(o1); }
            } else {
                const int d0 = 32 * wc + 4 * fq; const float qs = (hh >= 24 && hh < 28) ? C2_A : 1.0f;
#pragma unroll
                for (int ai = 0; ai < 2; ++ai)
#pragma unroll
                    for (int m = 0; m < 4; ++m) { const int s = u.pm * 256 + ai * 128 + wr * 64 + m * 16 + fr;
                        *(u32x2*)(hb + (size_t)s * 128 + d0) = pk4(acc[ai][bj][m][0] * qs); *(u32x2*)(hb + (size_t)s * 128 + d0 + 16) = pk4(acc[ai][bj][m][1] * qs); }
            }
        }
    }
};
struct EpiGate { bf16* G; const float* bias;
    static constexpr bool PERM = false, KSCALE = false, AFTER_DRAIN = false;
    __device__ __forceinline__ void operator()(const f32x4 (&acc)[2][2][4][2], const Unit& u, int wr, int wc, int fr, int fq) const {
#pragma unroll
        for (int bj = 0; bj < 2; ++bj)
#pragma unroll
            for (int n = 0; n < 2; ++n) { const int col = u.pn * 256 + bj * 128 + wc * 32 + n * 16 + 4 * fq; const f32x4 b = *(const f32x4*)(bias + col);
#pragma unroll
                for (int ai = 0; ai < 2; ++ai)
#pragma unroll
                    for (int m = 0; m < 4; ++m) { const int s = u.pm * 256 + ai * 128 + wr * 64 + m * 16 + fr; f32x4 v = acc[ai][bj][m][n] + b;
#pragma unroll
                        for (int r = 0; r < 4; ++r) v[r] = fmaxf(fsigmoid(v[r]), 1e-30f);
                        *(u32x2*)(G + (size_t)s * GW + col) = pk4(v); } }
    }
};
template <int MODE> struct EpiBr { const bf16* G; int goff, pad; float* MIX32; bf16* MIXB;
    static constexpr bool PERM = false, KSCALE = false, AFTER_DRAIN = false;
    __device__ __forceinline__ void operator()(const f32x4 (&acc)[2][2][4][2], const Unit& u, int wr, int wc, int fr, int fq) const {
#pragma unroll
        for (int ai = 0; ai < 2; ++ai)
#pragma unroll
            for (int m = 0; m < 4; ++m) { const int s = u.pm * 256 + ai * 128 + wr * 64 + m * 16 + fr;
#pragma unroll
                for (int bj = 0; bj < 2; ++bj)
#pragma unroll
                    for (int n = 0; n < 2; ++n) { const int col = u.pn * 256 + bj * 128 + wc * 32 + n * 16 + 4 * fq;
                        const f32x4 g = unpk4(*(const u32x2*)(G + (size_t)s * GW + goff + col)); f32x4 v = acc[ai][bj][m][n] * g; float* mp = MIX32 + (size_t)s * DM + col;
                        if (MODE >= 1) v += *(const f32x4*)mp;
                        if (MODE <= 1) *(f32x4*)mp = v; else *(u32x2*)(MIXB + (size_t)s * DM + col) = pk4(v); } }
    }
};
struct EpiBrF { const bf16* G; bf16* MIXB;
    static constexpr bool PERM = false, KSCALE = true, AFTER_DRAIN = false;
    __device__ __forceinline__ bool kscale_at(int t) const { return t == 16 || t == 24; }
    __device__ __forceinline__ void kscale(f32x4 (&acc)[2][2][4][2], const Unit& u, int t, int wr, int wc, int fr_, int fq_) const {
        int fr = fr_, fq = fq_; asm volatile("" : "+v"(fr), "+v"(fq));
        const int g_num = (t == 16) ? 0 : 2048, g_den = g_num + 2048;
#pragma unroll
        for (int ai = 0; ai < 2; ++ai)
#pragma unroll
            for (int m = 0; m < 4; ++m) { const int s = u.pm * 256 + ai * 128 + wr * 64 + m * 16 + fr;
#pragma unroll
                for (int bj = 0; bj < 2; ++bj)
#pragma unroll
                    for (int n = 0; n < 2; ++n) { const int col = u.pn * 256 + bj * 128 + wc * 32 + n * 16 + 4 * fq;
                        const f32x4 gn = unpk4(*(const u32x2*)(G + (size_t)s * GW + g_num + col)), gd = unpk4(*(const u32x2*)(G + (size_t)s * GW + g_den + col));
                        f32x4 r; r[0] = gn[0] * __builtin_amdgcn_rcpf(gd[0]); r[1] = gn[1] * __builtin_amdgcn_rcpf(gd[1]); r[2] = gn[2] * __builtin_amdgcn_rcpf(gd[2]); r[3] = gn[3] * __builtin_amdgcn_rcpf(gd[3]);
                        acc[ai][bj][m][n] = acc[ai][bj][m][n] * r; } }
    }
    __device__ __forceinline__ void operator()(const f32x4 (&acc)[2][2][4][2], const Unit& u, int wr, int wc, int fr_, int fq_) const {
        int fr = fr_, fq = fq_; asm volatile("" : "+v"(fr), "+v"(fq));
#pragma unroll
        for (int ai = 0; ai < 2; ++ai)
#pragma unroll
            for (int m = 0; m < 4; ++m) { const int s = u.pm * 256 + ai * 128 + wr * 64 + m * 16 + fr;
#pragma unroll
                for (int bj = 0; bj < 2; ++bj)
#pragma unroll
                    for (int n = 0; n < 2; ++n) { const int col = u.pn * 256 + bj * 128 + wc * 32 + n * 16 + 4 * fq;
                        const f32x4 g = unpk4(*(const u32x2*)(G + (size_t)s * GW + 4096 + col));
                        *(u32x2*)(MIXB + (size_t)s * DM + col) = pk4(acc[ai][bj][m][n] * g); } }
    }
};
struct EpiRes { const float* xres; float* V32;
    static constexpr bool PERM = false, KSCALE = false, AFTER_DRAIN = false;
    __device__ __forceinline__ void operator()(const f32x4 (&acc)[2][2][4][2], const Unit& u, int wr, int wc, int fr, int fq) const {
#pragma unroll
        for (int ai = 0; ai < 2; ++ai)
#pragma unroll
            for (int m = 0; m < 4; ++m) { const int s = u.pm * 256 + ai * 128 + wr * 64 + m * 16 + fr;
#pragma unroll
                for (int bj = 0; bj < 2; ++bj)
#pragma unroll
                    for (int n = 0; n < 2; ++n) { const size_t off = (size_t)s * DM + u.pn * 256 + bj * 128 + wc * 32 + n * 16 + 4 * fq;
                        *(f32x4*)(V32 + off) = *(const f32x4*)(xres + off) * ALPHA + acc[ai][bj][m][n]; } }
    }
};
struct EpiSwiGLU { bf16* F;
    static constexpr bool PERM = false, KSCALE = false, AFTER_DRAIN = false;
    __device__ __forceinline__ void operator()(const f32x4 (&acc)[2][2][4][2], const Unit& u, int wr, int wc, int fr, int fq) const {
#pragma unroll
        for (int ai = 0; ai < 2; ++ai)
#pragma unroll
            for (int m = 0; m < 4; ++m) { const int s = u.pm * 256 + ai * 128 + wr * 64 + m * 16 + fr;
#pragma unroll
                for (int bj = 0; bj < 2; ++bj) { const f32x4 g = acc[ai][bj][m][0], up = acc[ai][bj][m][1]; f32x4 v;
#pragma unroll
                    for (int r = 0; r < 4; ++r) v[r] = g[r] * fsigmoid(g[r]) * up[r];
                    *(u32x2*)(F + (size_t)s * FH + u.pn * 128 + bj * 64 + wc * 16 + 4 * fq) = pk4(v); } }
    }
};

struct Args { const float* in[21]; float* out; unsigned char* ws; };
struct Frame {
    LAS unsigned char* lds; volatile LAS unsigned* MISC; gu32* ctl;
    int tid, lane, wave, vcu, G;
};

__device__ __forceinline__ int colmap(int kind, int nb) {
    if (kind == 1) return ((nb & 1) ? FH : 0) + (nb >> 1) * 16;
    if (kind == 2) { const int hh = nb >> 3, blk = nb & 7, wc = blk >> 1, n = blk & 1;
        if (hh < 10) return hh * 128 + 16 * wc + 64 * n;
        if (hh >= 12 && hh < 20) return hh * 128 + 64 * (wc >> 1) + 16 * (wc & 1) + 32 * n;
        return nb * 16; }
    return nb * 16;
}
__device__ __forceinline__ void p0_transpose_item(const float* W, int dpitch, int Nsrc, int kind, bf16* WT, LAS float* scr, int item, int nblk, int lane) {
    const int kb = item / nblk, nb = item % nblk, k0 = 64 * kb, n0 = 32 * nb;
    const int scol = colmap(kind, 2 * nb + ((lane >> 4) & 1)) + (lane & 15);
#pragma unroll 8
    for (int i = 0; i < 32; ++i) { const int kk = 2 * i + (lane >> 5); scr[kk * 33 + (lane & 31)] = W[(size_t)(k0 + kk) * Nsrc + scol]; }
    asm volatile("s_waitcnt lgkmcnt(0)" ::: "memory");
    const int c = lane & 7;
#pragma unroll
    for (int j = 0; j < 4; ++j) { const int n = (lane >> 3) + 8 * j; const LAS float* s = scr + (8 * c) * 33 + n;
        u32x4 o; o.x = pk2(s[0 * 33], s[1 * 33]); o.y = pk2(s[2 * 33], s[3 * 33]); o.z = pk2(s[4 * 33], s[5 * 33]); o.w = pk2(s[6 * 33], s[7 * 33]);
        *(GAS u32x4*)(WT + (size_t)(n0 + n) * dpitch + k0 + 8 * c) = o; }
    asm volatile("s_waitcnt lgkmcnt(0)" ::: "memory");
}
struct WDesc { int src, K, Nsrc, Ndst, kind; size_t dst; };
__device__ __forceinline__ void p0_prologue(Frame& F, const Args& a) {
    LAS float* scr = (LAS float*)(F.lds + F.wave * 16384);
    const int gw = F.vcu * NWAVES + F.wave, NGW = F.G * NWAVES;
    unsigned char* ws = a.ws;
#define WCVT(SRC, K_, NSRC, NDST, KIND, DSTOFF, DPITCH) do { const int nblk = (NDST) / 32, nit = ((K_) / 64) * nblk; \
        for (int l = 0; l < DEPTH; ++l) { const float* Wl = a.in[SRC] + (size_t)l * (K_) * (NSRC); bf16* WTl = (bf16*)(ws + WS_W + (size_t)l * WL_SIZE + (DSTOFF)); \
            for (int it = gw; it < nit; it += NGW) p0_transpose_item(Wl, (DPITCH), (NSRC), (KIND), WTl, scr, it, nblk, F.lane); } } while (0)
    WCVT(1, DM, INW, INW, 2, WL_W1, DM);
    WCVT(12, DM, GW, GW, 0, WL_W1 + (size_t)INW * DM * 2, DM);
    WCVT(9, 1024, DM, DM, 0, WL_BA, DM);
    WCVT(10, 512, DM, DM, 0, WL_BA + 1024 * 2, DM);
    WCVT(11, 512, DM, DM, 0, WL_BA + 1536 * 2, DM);
    WCVT(14, DM, DM, DM, 0, WL_WO, DM);
    WCVT(17, DM, 2 * FH, 2 * FH, 1, WL_F1, DM);
    WCVT(18, FH, DM, DM, 0, WL_F2, FH);
#undef WCVT
    { const float* x = a.in[0]; bf16* xb = (bf16*)(ws + WS_XB);
        for (size_t i = ((size_t)blockIdx.x * 512 + F.tid) * 4; i < (size_t)S * DM; i += (size_t)F.G * 512 * 4) *(u32x2*)(xb + i) = pk4(*(const f32x4*)(x + i)); }
    { float* csa = (float*)(ws + WS_CSA); float* csb = (float*)(ws + WS_CSB);
        for (int idx = blockIdx.x * 512 + F.tid; idx < S * 96; idx += F.G * 512) { const int s = idx / 96, j = idx % 96;
            if (j < 64) { const float e = (float)(2 * j) / 128.0f; const float inv = 1.0f / powf(10000.0f, e); const float ang = (float)s * inv;
                csa[((size_t)s * 64 + j) * 2] = (float)cos((double)ang); csa[((size_t)s * 64 + j) * 2 + 1] = (float)sin((double)ang); }
            else { const int i = j - 64; const float e = (float)(2 * i) / 64.0f; const float inv = 1.0f / powf(10000.0f, e); const float ang = (float)s * inv;
                csb[((size_t)s * 32 + i) * 2] = (float)cos((double)ang); csb[((size_t)s * 32 + i) * 2 + 1] = (float)sin((double)ang); } } }
}

__device__ __forceinline__ void ln_phase(Frame& F, const float* V, const float* g, const float* b, float* xo, bf16* xb) {
    int lane_ = F.lane; asm volatile("" : "+v"(lane_));
    const int gw = F.vcu * NWAVES + F.wave, NGW = F.G * NWAVES, lane = lane_;
    for (int row = gw; row < S; row += NGW) {
        const f32x4* vr = (const f32x4*)(V + (size_t)row * DM) + lane;
        f32x4 v[8]; float s = 0.f;
#pragma unroll
        for (int j = 0; j < 8; ++j) { v[j] = vr[64 * j]; s += (v[j][0] + v[j][1]) + (v[j][2] + v[j][3]); }
        const float mean = wave_sum(s) * (1.f / DM); float q = 0.f;
#pragma unroll
        for (int j = 0; j < 8; ++j) { v[j] = v[j] - mean; q += (v[j][0] * v[j][0] + v[j][1] * v[j][1]) + (v[j][2] * v[j][2] + v[j][3] * v[j][3]); }
        const float rstd = 1.0f / sqrtf(wave_sum(q) * (1.f / DM) + LN_EPS);
#pragma unroll
        for (int j = 0; j < 8; ++j) { const int col = 4 * lane + 256 * j; const f32x4 gg = *(const f32x4*)(g + col), bb = *(const f32x4*)(b + col);
            const f32x4 y = v[j] * rstd * gg + bb; *(f32x4*)(xo + (size_t)row * DM + col) = y; *(u32x2*)(xb + (size_t)row * DM + col) = pk4(y); }
    }
}


namespace att {
typedef short s16x4 __attribute__((ext_vector_type(4)));
typedef float f32x16 __attribute__((ext_vector_type(16)));
constexpr int SHM_V = 16384, SHM_K = 16384;
constexpr int L_V = 0, L_K = 2 * SHM_V, L_WS = L_K + 2 * SHM_K, L_BIAS = L_WS + NWAVES * 64 * 4, L_END = L_BIAS + 2304;
constexpr float THR2 = 5.0f;
#define KSWZ(row, colB) ((row) * 256 + ((colB) ^ (((row) & 7) << 4)))
#define SBAR() __builtin_amdgcn_sched_barrier(0)
__device__ __forceinline__ int v_st(int k, int c) { const int kk = (k & ~0xC) | ((k & 4) << 1) | ((k & 8) >> 1); return ((kk >> 3) * 4 + (c >> 5)) * 512 + ((kk & 7) * 32 + (c & 31)) * 2; }
__device__ __forceinline__ int v_rd_base(int lane) { return ((lane & 3) << 3) | (((lane >> 2) & 3) << 6) | (((lane >> 4) & 1) << 5) | (((lane >> 5) & 1) << 8); }
constexpr int v_rd_off(int d0, int ks, int half) { return d0 * 512 + ks * 4096 + half * 2048; }
__device__ __forceinline__ int crow(int r, int hi) { return (r & 3) + 8 * (r >> 2) + 4 * hi; }
__device__ __forceinline__ unsigned cvtpk(float lo, float hi) { unsigned r; asm volatile("v_cvt_pk_bf16_f32 %0, %1, %2" : "=v"(r) : "v"(lo), "v"(hi)); return r; }

__device__ __forceinline__ void softmax_tile(f32x16& p0, f32x16& p1, float& m_reg, float& l_reg, float& alpha, bf16x8& pa0, bf16x8& pa1, bf16x8& pa2, bf16x8& pa3) {
    float pmax = p0[0];
#pragma unroll
    for (int r = 1; r < 16; ++r) pmax = fmaxf(pmax, p0[r]);
#pragma unroll
    for (int r = 0; r < 16; ++r) pmax = fmaxf(pmax, p1[r]);
    { auto rr = __builtin_amdgcn_permlane32_swap(__float_as_uint(pmax), __float_as_uint(pmax), false, false);
      pmax = fmaxf(__uint_as_float(rr[0]), __uint_as_float(rr[1])); }
    float mn;
    if (__all(pmax - m_reg <= THR2)) { mn = m_reg; alpha = 1.f; }
    else { mn = fmaxf(m_reg, pmax); alpha = __builtin_amdgcn_exp2f(m_reg - mn); m_reg = mn; }
#pragma unroll
    for (int r = 0; r < 16; ++r) p0[r] = __builtin_amdgcn_exp2f(p0[r] - mn);
#pragma unroll
    for (int r = 0; r < 16; ++r) p1[r] = __builtin_amdgcn_exp2f(p1[r] - mn);
    float ps = 0.f;
#pragma unroll
    for (int r = 0; r < 16; ++r) ps += p0[r];
#pragma unroll
    for (int r = 0; r < 16; ++r) ps += p1[r];
    { auto rr = __builtin_amdgcn_permlane32_swap(__float_as_uint(ps), __float_as_uint(ps), false, false);
      ps = __uint_as_float(rr[0]) + __uint_as_float(rr[1]); }
    l_reg = l_reg * alpha + ps;
#define PK4(P, B_, OUT) do { unsigned a0 = cvtpk(P[B_+0], P[B_+1]), a1 = cvtpk(P[B_+2], P[B_+3]);                          \
        unsigned b0 = cvtpk(P[B_+4], P[B_+5]), b1 = cvtpk(P[B_+6], P[B_+7]);                                             \
        auto r0 = __builtin_amdgcn_permlane32_swap(a0, b0, false, false); auto r1 = __builtin_amdgcn_permlane32_swap(a1, b1, false, false); \
        u32x4 w = {r0[0], r1[0], r0[1], r1[1]}; OUT = *reinterpret_cast<bf16x8*>(&w); } while (0)
    PK4(p0, 0, pa0); PK4(p0, 8, pa1); PK4(p1, 0, pa2); PK4(p1, 8, pa3);
#undef PK4
}
template <int KB, int ND>
__device__ __forceinline__ void qkt(f32x16& p0, f32x16& p1, const char* K_lds, int r32, int hi, const bf16x8* qr) {
    p0 = f32x16{}; p1 = f32x16{};
    const char* kb[4];
#pragma unroll
    for (int dd = 0; dd < 4; ++dd) kb[dd] = K_lds + KB * SHM_K + KSWZ(r32, (dd * 16 + hi * 8) * 2);
#pragma unroll
    for (int d0 = 0; d0 < ND; ++d0) { const char* a = kb[d0 & 3] + (d0 >> 2) * 128;
        bf16x8 b0 = *reinterpret_cast<const bf16x8*>(a);
        bf16x8 b1 = *reinterpret_cast<const bf16x8*>(a + 32 * 256);
        p0 = __builtin_amdgcn_mfma_f32_32x32x16_bf16(b0, qr[d0], p0, 0, 0, 0);
        p1 = __builtin_amdgcn_mfma_f32_32x32x16_bf16(b1, qr[d0], p1, 0, 0, 0); }
}
template <int VB>
__device__ __forceinline__ void pv_tile(f32x16* o, int vb0, bf16x8 pa0, bf16x8 pa1, bf16x8 pa2, bf16x8 pa3) {
#define TRRD(dst, off) asm volatile("ds_read_b64_tr_b16 %0, %1 offset:%2" : "=&v"(dst) : "v"(vb0), "i"(off) : "memory")
#define PV_D0(d0) do { s16x4 l0, l1, l2, l3, h0, h1, h2, h3; constexpr int b_ = VB * SHM_V + v_rd_off(d0, 0, 0); \
        TRRD(l0, b_); TRRD(h0, b_ + 2048); TRRD(l1, b_ + 4096); TRRD(h1, b_ + 6144); TRRD(l2, b_ + 8192); TRRD(h2, b_ + 10240); TRRD(l3, b_ + 12288); TRRD(h3, b_ + 14336); \
        asm volatile("s_waitcnt lgkmcnt(0)" ::: "memory"); SBAR();   \
        o[d0] = __builtin_amdgcn_mfma_f32_32x32x16_bf16(pa0, (bf16x8){l0[0], l0[1], l0[2], l0[3], h0[0], h0[1], h0[2], h0[3]}, o[d0], 0, 0, 0);   \
        o[d0] = __builtin_amdgcn_mfma_f32_32x32x16_bf16(pa1, (bf16x8){l1[0], l1[1], l1[2], l1[3], h1[0], h1[1], h1[2], h1[3]}, o[d0], 0, 0, 0);   \
        o[d0] = __builtin_amdgcn_mfma_f32_32x32x16_bf16(pa2, (bf16x8){l2[0], l2[1], l2[2], l2[3], h2[0], h2[1], h2[2], h2[3]}, o[d0], 0, 0, 0);   \
        o[d0] = __builtin_amdgcn_mfma_f32_32x32x16_bf16(pa3, (bf16x8){l3[0], l3[1], l3[2], l3[3], h3[0], h3[1], h3[2], h3[3]}, o[d0], 0, 0, 0); } while (0)
    PV_D0(0); PV_D0(1); PV_D0(2); PV_D0(3);
#undef PV_D0
#undef TRRD
}

struct UnitArgs {
    const bf16* Q;
    const bf16* K; const bf16* V;
    int t_lo, t_hi;
    int a_lo, a_hi;
    int koff;
    int qpos0;
    float m0, l0;
};
template <int MODE>
__device__ __forceinline__ void attn_unit(char* lds, const UnitArgs& U, f32x16 (&o)[4], float& m_reg, float& l_reg) {
    constexpr int ND = (MODE == 1) ? 4 : 8;
    int tid_ = threadIdx.x; asm volatile("" : "+v"(tid_));
    const int tid = tid_, lane = tid & 63, r32 = lane & 31, hi = lane >> 5; const int wid = __builtin_amdgcn_readfirstlane(tid >> 6);
    char* V_lds = lds + L_V; char* K_lds = lds + L_K;
    float* ws = (float*)(lds + L_WS) + wid * 64; float* al_l = ws + 32;
    const float* btab = (const float*)(lds + L_BIAS);
    const int sr = tid >> 4, sc = (tid & 15) * 8, vst0 = v_st(sr, sc), vst1 = v_st(32 + sr, sc), kws = KSWZ(sr, sc * 2);
    const int vb0 = (int)(uintptr_t)V_lds + v_rd_base(lane);
    const char* Kw = K_lds + U.koff;
    m_reg = U.m0; l_reg = U.l0;
#pragma unroll
    for (int d = 0; d < 4; ++d) o[d] = f32x16{};
    bf16x8 st_k0, st_k1, st_v0, st_v1;
#define SLOAD(t) do { const size_t ro_ = (size_t)(64 * (t) + sr) * 128 + sc; st_k0 = *(const bf16x8*)(U.K + ro_); st_k1 = *(const bf16x8*)(U.K + ro_ + 32 * 128); \
                      st_v0 = *(const bf16x8*)(U.V + ro_); st_v1 = *(const bf16x8*)(U.V + ro_ + 32 * 128); } while (0)
#define SWRITE(bf) do { *(bf16x8*)(K_lds + (bf) * SHM_K + kws) = st_k0; *(bf16x8*)(K_lds + (bf) * SHM_K + kws + 32 * 256) = st_k1; \
                        *(bf16x8*)(V_lds + (bf) * SHM_V + vst0) = st_v0; *(bf16x8*)(V_lds + (bf) * SHM_V + vst1) = st_v1; } while (0)
    bf16x8 qr[ND];
#pragma unroll
    for (int d0 = 0; d0 < ND; ++d0) qr[d0] = *(const bf16x8*)(U.Q + (size_t)r32 * 128 + d0 * 16 + hi * 8);
    SBAR();
    SLOAD(U.t_lo);
    SWRITE(0);
    __syncthreads();
#define STEP(t, B) do { \
        if ((t) + 1 < U.t_hi) SLOAD((t) + 1); SBAR(); \
        if ((t) >= U.a_lo && (t) <= U.a_hi) { \
            f32x16 p0, p1; float alpha; bf16x8 pa0, pa1, pa2, pa3; \
            qkt<B, ND>(p0, p1, Kw, r32, hi, qr); \
            if (MODE == 2) { const int dq = U.qpos0 + r32 - 64 * (t) - 4 * hi; \
                _Pragma("unroll") for (int r = 0; r < 16; ++r) { const int c_ = (r & 3) + 8 * (r >> 2); int d0_ = dq - c_, d1_ = dq - c_ - 32; \
                    d0_ = d0_ < -256 ? -256 : (d0_ > 256 ? 256 : d0_); d1_ = d1_ < -256 ? -256 : (d1_ > 256 ? 256 : d1_); p0[r] += btab[d0_ + 256]; p1[r] += btab[d1_ + 256]; } } \
            softmax_tile(p0, p1, m_reg, l_reg, alpha, pa0, pa1, pa2, pa3); \
            if (__any(alpha < 1.f)) { if (hi == 0) al_l[r32] = alpha; asm volatile("s_waitcnt lgkmcnt(0)" ::: "memory"); \
                _Pragma("unroll") for (int d_ = 0; d_ < 4; ++d_) _Pragma("unroll") for (int r = 0; r < 16; ++r) o[d_][r] *= al_l[crow(r, hi)]; } \
            SBAR(); pv_tile<B>(o, vb0, pa0, pa1, pa2, pa3); } \
        SBAR(); if ((t) + 1 < U.t_hi) SWRITE((B) ^ 1); \
        __syncthreads(); } while (0)
    for (int t = U.t_lo; t < U.t_hi; t += 2) { STEP(t, 0); if (t + 1 < U.t_hi) STEP(t + 1, 1); }
#undef STEP
#undef SLOAD
#undef SWRITE
}
template <class T>
__device__ __forceinline__ void attn_store(char* lds, const f32x16 (&o)[4], float l_reg, T* Ow, int ldo) {
    int tid_ = threadIdx.x; asm volatile("" : "+v"(tid_));
    const int tid = tid_, lane = tid & 63, r32 = lane & 31, hi = lane >> 5; const int wid = __builtin_amdgcn_readfirstlane(tid >> 6);
    float* li_l = (float*)(lds + L_WS) + wid * 64;
    if (hi == 0) li_l[r32] = l_reg; asm volatile("s_waitcnt lgkmcnt(0)" ::: "memory");
#pragma unroll
    for (int r = 0; r < 16; ++r) { const int orow = crow(r, hi); const float lv = li_l[orow]; const float rl = lv > 0.f ? __builtin_amdgcn_rcpf(lv) : 0.f;
#pragma unroll
        for (int d0 = 0; d0 < 4; ++d0) { const float v = o[d0][r] * rl;
            if constexpr (sizeof(T) == 4) { Ow[(size_t)orow * ldo + d0 * 32 + r32] = v; }
            else { const float vn = __shfl_xor(v, 1); if ((r32 & 1) == 0) *(unsigned*)(Ow + (size_t)orow * ldo + d0 * 32 + r32) = cvtpk(v, vn); } } }
    asm volatile("s_waitcnt lgkmcnt(0)" ::: "memory");
}
#undef KSWZ
#undef SBAR
}

__device__ __forceinline__ void attn_phase(Frame& F, char* lds, const bf16* QKV, bf16* Y, float* PB, float* PML, const float* sinks, const float* relb) {
    int tid_ = threadIdx.x; asm volatile("" : "+v"(tid_));
    const int wid = __builtin_amdgcn_readfirstlane(tid_ >> 6), lane = tid_ & 63;
    att::f32x16 o[4]; float m_reg, l_reg;
    for (int w = F.vcu; w < 256; w += F.G) { const int h = w >> 6, jj = w & 63;
#pragma unroll 1
        for (int half = 0; half < 2; ++half) { const int j = half ? 63 - jj : jj; const int comp = wid >> 2, row0 = 128 * j + 32 * (wid & 3), cw = 2 * j + ((wid & 3) >> 1);
            att::UnitArgs U; U.Q = QKV + O_QB + (size_t)h * HS + (size_t)row0 * 128 + comp * 64; U.K = QKV + O_KB + (size_t)h * HS; U.V = QKV + O_VB + (size_t)h * HS;
            U.t_lo = half ? j + 1 : 0; U.t_hi = half ? 2 * j + 2 : j + 1; U.a_lo = 0; U.a_hi = cw; U.koff = comp * 128; U.qpos0 = 0; U.m0 = -1e30f; U.l0 = 0.f;
            att::attn_unit<1>(lds, U, o, m_reg, l_reg);
            const size_t pidx = ((size_t)(half * 4 + h) * 2 + comp) * S + row0;
            att::attn_store<float>(lds, o, l_reg, PB + pidx * 128, 128);
            if (lane < 32) { float* ml = PML + (pidx + lane) * 2; ml[0] = m_reg; ml[1] = l_reg; } } }
    for (int w = F.vcu; w < 128; w += F.G) { const int h = w >> 5, j = w & 31; const int cw = 4 * j + (wid >> 1), row0 = 64 * cw + 32 * (wid & 1);
        { float* bt = (float*)(lds + att::L_BIAS); for (int i = tid_; i < 513; i += NWAVES * 64) bt[i] = relb[h * 513 + i] * LOG2E; }
        att::UnitArgs U; U.Q = QKV + O_QC + (size_t)h * HS + (size_t)row0 * 128; U.K = QKV + O_KC + (size_t)h * HS; U.V = QKV + O_VC + (size_t)h * HS;
        U.t_lo = 4 * j >= 8 ? 4 * j - 8 : 0; U.t_hi = 4 * j + 4; U.a_lo = cw - 8; U.a_hi = cw; U.koff = 0; U.qpos0 = row0; U.m0 = -1e30f; U.l0 = 0.f;
        att::attn_unit<2>(lds, U, o, m_reg, l_reg);
        att::attn_store<bf16>(lds, o, l_reg, Y + (size_t)row0 * DM + 1536 + h * 128, DM); }
    for (int w = F.vcu; w < 256; w += F.G) { const int kvh = w >> 7, c = w & 127; const int hq = kvh * 4 + (wid >> 1), row0 = 64 * c + 32 * (wid & 1);
        att::UnitArgs U; U.Q = QKV + O_QA + (size_t)hq * HS + (size_t)row0 * 128; U.K = QKV + O_KA + (size_t)kvh * HS; U.V = QKV + O_VA + (size_t)kvh * HS;
        U.t_lo = c >= 2 ? c - 2 : 0; U.t_hi = c + 1; U.a_lo = 0; U.a_hi = c; U.koff = 0; U.qpos0 = 0; U.m0 = sinks[hq] * LOG2E; U.l0 = 1.0f;
        att::attn_unit<0>(lds, U, o, m_reg, l_reg);
        att::attn_store<bf16>(lds, o, l_reg, Y + (size_t)row0 * DM + hq * 128, DM); }
}
__device__ __forceinline__ void attn_b_combine(Frame& F, const float* PB, const float* PML, bf16* Y, const float* lq1, const float* lk1, const float* lq2, const float* lk2, const float* subg, float lam_init) {
    int lane_ = F.lane; asm volatile("" : "+v"(lane_));
    const int gw = F.vcu * NWAVES + F.wave, NGW = F.G * NWAVES, lane = lane_;
    const float lam = expf(wave_sum(lq1[lane] * lk1[lane])) - expf(wave_sum(lq2[lane] * lk2[lane])) + lam_init;
    const float g0 = subg[2 * lane], g1 = subg[2 * lane + 1];
    for (int it = gw; it < 4 * S; it += NGW) { const int s = it >> 2, h = it & 3;
        float oc[2][2];
#pragma unroll
        for (int comp = 0; comp < 2; ++comp) {
            const size_t i0 = ((size_t)(0 * 4 + h) * 2 + comp) * S + s, i1 = ((size_t)(1 * 4 + h) * 2 + comp) * S + s;
            const f32x2 ml0 = *(const f32x2*)(PML + i0 * 2), ml1 = *(const f32x2*)(PML + i1 * 2);
            const float M = fmaxf(ml0[0], ml1[0]); const float w0 = ml0[1] * __builtin_amdgcn_exp2f(ml0[0] - M), w1 = ml1[1] * __builtin_amdgcn_exp2f(ml1[0] - M);
            const float inv = 1.0f / (w0 + w1);
            const f32x2 a = *(const f32x2*)(PB + i0 * 128 + 2 * lane), b = *(const f32x2*)(PB + i1 * 128 + 2 * lane);
            oc[comp][0] = (w0 * a[0] + w1 * b[0]) * inv; oc[comp][1] = (w0 * a[1] + w1 * b[1]) * inv; }
        const float d0 = oc[0][0] - lam * oc[1][0], d1 = oc[0][1] - lam * oc[1][1];
        const float r = 1.0f / sqrtf(wave_sum(d0 * d0 + d1 * d1) * (1.f / 128.f) + LN_EPS) * (1.0f - lam_init);
        *(unsigned*)(Y + (size_t)s * DM + 1024 + h * 128 + 2 * lane) = pk2(d0 * r * g0, d1 * r * g1); }
}
#define REP_PRO 1
#define REP_P1 1
#define REP_ATT 1
#define REP_BR 1
#define REP_OUT 1
#define REP_LN 1
#define REP_F1 1
#define REP_F2 1
__global__ void __launch_bounds__(NWAVES * 64, 2) mk_fwd(Args args) {
    extern __shared__ __attribute__((aligned(16))) unsigned char lds[];
    Frame F;
    F.lds = (LAS unsigned char*)lds; F.MISC = (volatile LAS unsigned*)(F.lds + MISC_OFF);
    F.tid = threadIdx.x; F.lane = F.tid & 63; F.wave = __builtin_amdgcn_readfirstlane(F.tid >> 6);
    F.G = gridDim.x; { const int bx = blockIdx.x; F.vcu = (F.G % 8 == 0) ? (bx % 8) * (F.G / 8) + bx / 8 : bx; }
    unsigned char* ws = args.ws; F.ctl = (gu32*)(ws + WS_CTL);
    for (int u = F.tid; u < (LDS_BYTES - LDSCTL_OFF) / 4; u += NWAVES * 64) ((LAS unsigned*)(F.lds + LDSCTL_OFF))[u] = 0u;
    __syncthreads();
    XcdBarrier bar = xcd_barrier_post((unsigned*)(F.ctl + CW_BAR), F.MISC + 8);
#define GRID_BAR() xcd_barrier_t<false>(bar)
#define PHASE_VARS GAS unsigned char* wsp = (GAS unsigned char*)ws; GAS float* outg = (GAS float*)args.out; int cbx = (int)blockIdx.x, Gx = F.G; asm volatile("" : "+s"(wsp), "+s"(outg), "+s"(cbx), "+s"(Gx)); float* outp = (float*)outg; \
    bf16* XB = (bf16*)(wsp + WS_XB); bf16* QKV = (bf16*)(wsp + WS_QKV); bf16* G = (bf16*)(wsp + WS_G); bf16* Y = (bf16*)(wsp + WS_Y); bf16* MIXB = (bf16*)(wsp + WS_MIXB); bf16* FB = (bf16*)(wsp + WS_F); \
    float* CSA = (float*)(wsp + WS_CSA); float* CSB = (float*)(wsp + WS_CSB); float* V32 = (float*)(wsp + WS_V32); float* MIX32 = (float*)(wsp + WS_MIX32); \
    const unsigned char* Wl = (const unsigned char*)(wsp + WS_W + (size_t)l * WL_SIZE); \
    (void)XB; (void)QKV; (void)G; (void)Y; (void)MIXB; (void)FB; (void)CSA; (void)CSB; (void)V32; (void)MIX32; (void)Wl; (void)outp; (void)cbx; (void)Gx

    for (int rep = 0; rep < REP_PRO; ++rep) p0_prologue(F, args);
    xcd_barrier_t<true>(bar);

    for (int l = 0; l < DEPTH; ++l) {
        for (int rep = 0; rep < REP_P1; ++rep) { PHASE_VARS;
          { pg8::Gemm g{XB, (const bf16*)(Wl + WL_W1), DM, DM}; pg8::StaticOrder So; So.init(S, INW, Gx, cbx);
            EpiIn E{QKV, CSA, CSB}; pg8::gemm_phase<EpiIn, pg8::StaticOrder, true>(F.lds, g, So, E); }
          { pg8::Gemm g{XB, (const bf16*)(Wl + WL_W1 + (size_t)INW * DM * 2), DM, DM}; pg8::StaticOrder So; So.init(S, GW, Gx, cbx);
            EpiGate E{G, args.in[13] + (size_t)l * GW}; pg8::gemm_phase<EpiGate, pg8::StaticOrder, true>(F.lds, g, So, E); } }
        GRID_BAR();
        for (int rep = 0; rep < REP_ATT; ++rep) { PHASE_VARS; attn_phase(F, (char*)lds, QKV, Y, (float*)(wsp + WS_PB), (float*)(wsp + WS_PML), args.in[2] + l * 8, args.in[8] + (size_t)l * 4 * 513); }
        GRID_BAR();
        { PHASE_VARS; const float lam_init = 0.8f - 0.6f * expf(-0.3f * (float)l);
          attn_b_combine(F, (const float*)(wsp + WS_PB), (const float*)(wsp + WS_PML), Y, args.in[3] + l * 64, args.in[4] + l * 64, args.in[5] + l * 64, args.in[6] + l * 64, args.in[7] + l * 128, lam_init); }
        GRID_BAR();
        for (int rep = 0; rep < REP_BR; ++rep) { PHASE_VARS; pg8::StaticOrder So; So.init(S, DM, Gx, cbx);
          pg8::Gemm g{Y, (const bf16*)(Wl + WL_BA), DM, DM}; EpiBrF E{G, MIXB}; pg8::gemm_phase<EpiBrF, pg8::StaticOrder, false>(F.lds, g, So, E); }
        GRID_BAR();
        for (int rep = 0; rep < REP_OUT; ++rep) { PHASE_VARS; const float* xres = (l == 0) ? args.in[0] : (const float*)outp;
          pg8::Gemm g{MIXB, (const bf16*)(Wl + WL_WO), DM, DM}; pg8::StaticOrder So; So.init(S, DM, Gx, cbx);
          EpiRes E{xres, V32}; pg8::gemm_phase<EpiRes, pg8::StaticOrder, false>(F.lds, g, So, E); }
        GRID_BAR();
        for (int rep = 0; rep < REP_LN; ++rep) { PHASE_VARS; ln_phase(F, V32, args.in[15] + (size_t)l * DM, args.in[16] + (size_t)l * DM, outp, XB); }
        GRID_BAR();
        for (int rep = 0; rep < REP_F1; ++rep) { PHASE_VARS; pg8::Gemm g{XB, (const bf16*)(Wl + WL_F1), DM, DM}; pg8::StaticOrder So; So.init(S, 2 * FH, Gx, cbx);
          EpiSwiGLU E{FB}; pg8::gemm_phase<EpiSwiGLU, pg8::StaticOrder, true>(F.lds, g, So, E); }
        GRID_BAR();
        for (int rep = 0; rep < REP_F2; ++rep) { PHASE_VARS; pg8::Gemm g{FB, (const bf16*)(Wl + WL_F2), FH, FH}; pg8::StaticOrder So; So.init(S, DM, Gx, cbx);
          EpiRes E{outp, V32}; pg8::gemm_phase<EpiRes, pg8::StaticOrder, false>(F.lds, g, So, E); }
        GRID_BAR();
        { PHASE_VARS; ln_phase(F, V32, args.in[19] + (size_t)l * DM, args.in[20] + (size_t)l * DM, outp, XB); }
        GRID_BAR();
    }
}

extern "C" void kernel_launch(void* const* d_in, const int* in_sizes, int n_in, void* d_out, int out_size, void* d_ws, size_t ws_size, hipStream_t stream) {
    static int grid = 0;
    if (grid == 0) {
        if (n_in != 21 || out_size != S * DM || ws_size < WS_END) { fprintf(stderr, "kernel_launch: unexpected shapes (n_in %d out %d ws %zu need %zu)\n", n_in, out_size, ws_size, (size_t)WS_END); grid = -1; return; }
        int dev = 0, cus = 0, per_cu = 0;
        if (hipGetDevice(&dev) != hipSuccess || hipDeviceGetAttribute(&cus, hipDeviceAttributeMultiprocessorCount, dev) != hipSuccess) { grid = -1; return; }
        if (hipFuncSetAttribute((const void*)mk_fwd, hipFuncAttributeMaxDynamicSharedMemorySize, LDS_BYTES) != hipSuccess) { fprintf(stderr, "kernel_launch: hipFuncSetAttribute failed\n"); grid = -1; return; }
        if (hipOccupancyMaxActiveBlocksPerMultiprocessor(&per_cu, (const void*)mk_fwd, NWAVES * 64, LDS_BYTES) != hipSuccess || per_cu < 1) fprintf(stderr, "kernel_launch: occupancy query reports %d\n", per_cu);
        (void)hipGetLastError();
        grid = cus;
    }
    if (grid < 0) return;
    if (hipMemsetAsync((char*)d_ws + WS_CTL, 0, CTL_ZERO_BYTES, stream) != hipSuccess) return;
    Args a{};
    for (int i = 0; i < 21; ++i) a.in[i] = (const float*)d_in[i];
    a.out = (float*)d_out; a.ws = (unsigned char*)d_ws;
    hipLaunchKernelGGL(mk_fwd, dim3(grid), dim3(NWAVES * 64), LDS_BYTES, stream, a);
}
```
